# Optimizing an MI355X kernel written in HIP

```python
import math
import jax, jax.numpy as jnp
from jax import lax
import numpy as np


D_MODEL = 2048
BATCH = 1
SEQ = 8192
DEPTH = 4

MEM_LEN = 256
GLA_HEADS = 4
GLA_DK = 128
GLA_DV = 256
GLA_GATE_RANK = 16
GLA_GATE_NORMALIZER = 16.0
GLA_CHUNK = 64
DIL_HEADS = 4
DIL_HEAD_DIM = 128
DIL_CONFIGS = ((128, 1), (512, 4), (2048, 16))
MEM_HEADS = 4
MEM_HEAD_DIM = 128
REL_BUCKETS = 32
REL_MAX_DISTANCE = 1024
D_FF = 4 * D_MODEL
EPS = 1e-6
NEG_INF = -1e30

GLA_QK_WIDTH = GLA_HEADS * GLA_DK
GLA_V_WIDTH = GLA_HEADS * GLA_DV
DIL_WIDTH = DIL_HEADS * DIL_HEAD_DIM
MEM_WIDTH = MEM_HEADS * MEM_HEAD_DIM
MIX_WIDTH = GLA_V_WIDTH + DIL_WIDTH + MEM_WIDTH
IN_SPLITS = (GLA_QK_WIDTH, GLA_QK_WIDTH, GLA_V_WIDTH, GLA_V_WIDTH, GLA_GATE_RANK, GLA_GATE_RANK,
             DIL_WIDTH, DIL_WIDTH, DIL_WIDTH, MEM_WIDTH)
IN_WIDTH = 2 * GLA_QK_WIDTH + 2 * GLA_V_WIDTH + 2 * GLA_GATE_RANK + 3 * DIL_WIDTH + MEM_WIDTH

kernel_name = 'hymba_gla_dilated_memxattn_encoder'


def rms_norm(x, gain):
    xf = x.astype(jnp.float32)
    y = xf * lax.rsqrt(jnp.mean(xf * xf, axis=-1, keepdims=True) + EPS)
    return (y * gain.astype(jnp.float32)).astype(x.dtype)


def head_rms_norm(x, gain):
    h, e = x.shape[-2:]
    xf = x.astype(jnp.float32)
    y = xf * lax.rsqrt(jnp.mean(xf * xf, axis=-1, keepdims=True) + EPS)
    return y * gain.reshape(h, e).astype(jnp.float32)


def split_columns(t, sizes):
    outs, start = [], 0
    for s in sizes:
        outs.append(t[..., start:start + s])
        start += s
    return outs


def t5_bucket(rel):
    half = REL_BUCKETS // 2
    max_exact = half // 2
    ret = jnp.where(rel > 0, half, 0)
    n = jnp.abs(rel)
    nf = jnp.maximum(n, 1).astype(jnp.float32)
    large = max_exact + (jnp.log(nf / max_exact) / math.log(REL_MAX_DISTANCE / max_exact)
                         * (half - max_exact)).astype(jnp.int32)
    large = jnp.minimum(large, half - 1)
    return ret + jnp.where(n < max_exact, n, large)


def gla_direction(q, k, v, g):
    b_, h_, s_, dk = q.shape
    dv = v.shape[-1]
    c = GLA_CHUNK
    n = s_ // c
    q, k, g = [t.reshape(b_, h_, n, c, dk) for t in (q, k, g)]
    v = v.reshape(b_, h_, n, c, dv)
    b = jnp.cumsum(g, axis=3)
    b_last = b[:, :, :, -1:, :]
    q_dec = q * jnp.exp(b)
    k_inv = k * jnp.exp(-b)
    k_end = k * jnp.exp(b_last - b)
    causal = jnp.tril(jnp.ones((c, c), dtype=bool))
    a = jnp.where(causal, jnp.einsum('bhncd,bhnsd->bhncs', q_dec, k_inv), 0.0)
    o_intra = jnp.einsum('bhncs,bhnsv->bhncv', a, v)
    d_state = jnp.einsum('bhncd,bhncv->nbhdv', k_end, v)
    decay = jnp.moveaxis(jnp.exp(b_last[:, :, :, 0, :]), 2, 0)
    q_chunks = jnp.moveaxis(q_dec, 2, 0)

    def step(state, inp):
        ds, dec, qc = inp
        out = jnp.einsum('bhcd,bhdv->bhcv', qc, state)
        return dec[..., None] * state + ds, out

    state0 = jnp.zeros((b_, h_, dk, dv), dtype=q.dtype)
    _, o_inter = lax.scan(step, state0, (d_state, decay, q_chunks))
    o = o_intra + jnp.moveaxis(o_inter, 0, 2)
    return o.reshape(b_, h_, s_, dv)


def gla_mixer(q, k, v, r, lr_f, lr_b, up_f, bias_f, up_b, bias_b, norm_gain):
    b_, s_ = q.shape[:2]

    def heads(t, e):
        return t.reshape(b_, s_, GLA_HEADS, e).transpose(0, 2, 1, 3).astype(jnp.float32)

    def log_gate(lr, up, bias):
        logits = (jnp.einsum('bsr,rk->bsk', lr, up) + bias).astype(jnp.float32)
        return heads(jax.nn.log_sigmoid(logits) / GLA_GATE_NORMALIZER, GLA_DK)

    qh = heads(q, GLA_DK) * (GLA_DK ** -0.5)
    kh = heads(k, GLA_DK)
    vh = heads(v, GLA_DV)
    g_f = log_gate(lr_f, up_f, bias_f)
    g_b = log_gate(lr_b, up_b, bias_b)
    o_f = gla_direction(qh, kh, vh, g_f)
    flip = lambda t: jnp.flip(t, axis=2)
    o_b = flip(gla_direction(flip(qh), flip(kh), flip(vh), flip(g_b)))
    o = (o_f + o_b).transpose(0, 2, 1, 3)
    gate = jax.nn.silu(r.reshape(b_, s_, GLA_HEADS, GLA_DV).astype(jnp.float32))
    o = head_rms_norm(o, norm_gain) * gate
    return o.reshape(b_, s_, GLA_V_WIDTH)


def dilated_branch(q, k, v, rel_table, window, dilation):
    b_, s_, h_, e = q.shape
    w = window // (2 * dilation)
    l = s_ // dilation
    nb = -(-l // w)
    lp = nb * w

    def stride(t):
        return t.reshape(b_, l, dilation, h_, e).transpose(0, 2, 3, 1, 4)

    qs = jnp.pad(stride(q), ((0, 0), (0, 0), (0, 0), (0, lp - l), (0, 0))).reshape(b_, dilation, h_, nb, w, e)

    def windows(t):
        tp = jnp.pad(stride(t), ((0, 0), (0, 0), (0, 0), (w, lp - l + w), (0, 0)))
        tp = tp.reshape(b_, dilation, h_, nb + 2, w, e)
        return jnp.concatenate([tp[:, :, :, :-2], tp[:, :, :, 1:-1], tp[:, :, :, 2:]], axis=4)

    kw = windows(k)
    vw = windows(v)
    rel_sub = jnp.arange(3 * w)[None, :] - w - jnp.arange(w)[:, None]
    bias = jnp.transpose(rel_table[t5_bucket(rel_sub * dilation)], (2, 0, 1)).astype(jnp.float32)
    key_pos = jnp.arange(nb)[:, None] * w - w + jnp.arange(3 * w)[None, :]
    mask = (jnp.abs(rel_sub) <= w)[None] & ((key_pos >= 0) & (key_pos < l))[:, None, :]
    s = jnp.einsum('bdhnqe,bdhnke->bdhnqk', qs, kw, preferred_element_type=jnp.float32) * (e ** -0.5)
    s = jnp.where(mask, s + bias[None, None, :, None], NEG_INF)
    m = jnp.max(s, axis=-1, keepdims=True)
    p = jnp.exp(s - m)
    den = jnp.sum(p, axis=-1, keepdims=True)
    o = jnp.einsum('bdhnqk,bdhnke->bdhnqe', p, vw.astype(jnp.float32)) / den
    lse = m + jnp.log(den)

    def unstride(t):
        t = t.reshape(b_, dilation, h_, lp, t.shape[-1])[:, :, :, :l]
        return t.transpose(0, 3, 1, 2, 4).reshape(b_, s_, h_, t.shape[-1])

    return unstride(o), unstride(lse)[..., 0]


def dilated_mixer(q, k, v, rel_table, norm_gain):
    b_, s_ = q.shape[:2]
    qh, kh, vh = [t.reshape(b_, s_, DIL_HEADS, DIL_HEAD_DIM) for t in (q, k, v)]
    outs, lses = [], []
    for window, dilation in DIL_CONFIGS:
        o, lse = dilated_branch(qh, kh, vh, rel_table, window, dilation)
        outs.append(o)
        lses.append(lse)
    weights = jax.nn.softmax(jnp.stack(lses, axis=0), axis=0)
    o = jnp.einsum('rbsh,rbshe->bshe', weights, jnp.stack(outs, axis=0))
    return head_rms_norm(o, norm_gain).reshape(b_, s_, DIL_WIDTH)


def memory_mixer(q, mem, mem_gain, w_mem_kv, norm_gain):
    b_, s_ = q.shape[:2]
    qh = q.reshape(b_, s_, MEM_HEADS, MEM_HEAD_DIM)
    kv = jnp.einsum('bmd,dk->bmk', rms_norm(mem, mem_gain), w_mem_kv)
    km, vm = [t.reshape(b_, mem.shape[1], MEM_HEADS, MEM_HEAD_DIM) for t in split_columns(kv, (MEM_WIDTH, MEM_WIDTH))]
    s = jnp.einsum('bshe,bmhe->bhsm', qh, km, preferred_element_type=jnp.float32) * (MEM_HEAD_DIM ** -0.5)
    p = jax.nn.softmax(s, axis=-1)
    o = jnp.einsum('bhsm,bmhe->bshe', p, vm.astype(jnp.float32))
    return head_rms_norm(o, norm_gain).reshape(b_, s_, MEM_WIDTH)


def setup_inputs(seed: int = 0) -> dict:
    key = jax.random.key(seed)
    ks = jax.random.split(key, 24)
    f32 = jnp.float32
    nrm = lambda k, shape, scale: jax.random.normal(k, shape, f32) * scale
    gain = lambda k, shape: 1.0 + 0.02 * jax.random.normal(k, shape, f32)
    return {
        'x': nrm(ks[0], (BATCH, SEQ, D_MODEL), 1.0),
        'mem': nrm(ks[1], (BATCH, MEM_LEN, D_MODEL), 1.0),
        'norm_mix': gain(ks[2], (DEPTH, D_MODEL)),
        'w_in': nrm(ks[3], (DEPTH, D_MODEL, IN_WIDTH), D_MODEL ** -0.5),
        'gla_gate_up_fwd': nrm(ks[4], (DEPTH, GLA_GATE_RANK, GLA_QK_WIDTH), GLA_GATE_RANK ** -0.5),
        'gla_gate_bias_fwd': nrm(ks[5], (DEPTH, GLA_QK_WIDTH), 0.1),
        'gla_gate_up_bwd': nrm(ks[6], (DEPTH, GLA_GATE_RANK, GLA_QK_WIDTH), GLA_GATE_RANK ** -0.5),
        'gla_gate_bias_bwd': nrm(ks[7], (DEPTH, GLA_QK_WIDTH), 0.1),
        'gla_norm': gain(ks[8], (DEPTH, GLA_V_WIDTH)),
        'rel_bias': nrm(ks[9], (REL_BUCKETS, DIL_HEADS), 0.5),
        'dil_norm': gain(ks[10], (DEPTH, DIL_WIDTH)),
        'mem_norm': gain(ks[11], (DEPTH, D_MODEL)),
        'w_mem_kv': nrm(ks[12], (DEPTH, D_MODEL, 2 * MEM_WIDTH), D_MODEL ** -0.5),
        'mem_out_norm': gain(ks[13], (DEPTH, MEM_WIDTH)),
        'w_out': nrm(ks[14], (DEPTH, MIX_WIDTH, D_MODEL), MIX_WIDTH ** -0.5),
        'norm_mlp': gain(ks[15], (DEPTH, D_MODEL)),
        'w_up': nrm(ks[16], (DEPTH, D_MODEL, D_FF), D_MODEL ** -0.5),
        'w_down': nrm(ks[17], (DEPTH, D_FF, D_MODEL), D_FF ** -0.5),
        'norm_final': gain(ks[18], (D_MODEL,)),
    }


def reference(x, mem, norm_mix, w_in, gla_gate_up_fwd, gla_gate_bias_fwd, gla_gate_up_bwd, gla_gate_bias_bwd,
              gla_norm, rel_bias, dil_norm, mem_norm, w_mem_kv, mem_out_norm, w_out, norm_mlp, w_up, w_down,
              norm_final):
    for l in range(DEPTH):
        h = rms_norm(x, norm_mix[l])
        proj = jnp.einsum('bsd,dk->bsk', h, w_in[l])
        (g_q, g_k, g_v, g_r, lr_f, lr_b, d_q, d_k, d_v, m_q) = split_columns(proj, IN_SPLITS)
        gla_out = gla_mixer(g_q, g_k, g_v, g_r, lr_f, lr_b, gla_gate_up_fwd[l], gla_gate_bias_fwd[l],
                            gla_gate_up_bwd[l], gla_gate_bias_bwd[l], gla_norm[l])
        dil_out = dilated_mixer(d_q, d_k, d_v, rel_bias, dil_norm[l])
        mem_out = memory_mixer(m_q, mem, mem_norm[l], w_mem_kv[l], mem_out_norm[l])
        mixed = jnp.concatenate([gla_out, dil_out, mem_out], axis=-1).astype(x.dtype)
        x = x + jnp.einsum('bsk,kd->bsd', mixed, w_out[l])
        h = rms_norm(x, norm_mlp[l])
        u = jnp.square(jax.nn.relu(jnp.einsum('bsd,df->bsf', h, w_up[l])))
        x = x + jnp.einsum('bsf,fd->bsd', u, w_down[l])
    return rms_norm(x, norm_final)
```

```cpp
#include <hip/hip_runtime.h>
#include <hip/hip_cooperative_groups.h>
#include <cstdio>
#include <cstdint>
namespace cg = cooperative_groups;

#ifndef MK_MULTI
#define MK_MULTI 0
#endif

#ifndef DBG_LAST
#define DBG_LAST 1000
#endif
#define LAS __attribute__((address_space(3)))
typedef unsigned short bf16_t;
typedef short bf16x8 __attribute__((ext_vector_type(8)));
typedef short s16x4 __attribute__((ext_vector_type(4)));
typedef short v4i16_t __attribute__((ext_vector_type(4)));
typedef float f32x4 __attribute__((ext_vector_type(4)));
typedef float f32x2 __attribute__((ext_vector_type(2)));
typedef unsigned u32x4 __attribute__((ext_vector_type(4)));
typedef unsigned u32x2 __attribute__((ext_vector_type(2)));

constexpr int SEQ = 8192, DM = 2048, DEPTH = 4, DFF = 8192, MEML = 256;
constexpr int NIN = 5376;
constexpr int NIN_SRC = 5152;
constexpr int PQ = 0, PK = 512, PV = 1024, PR = 2048, DQ = 3072, DKo = 3584, DVo = 4096, MQ = 4608, LRF = 5120;
constexpr float EPS = 1e-6f;
constexpr float QSCALE = 0.08838834764831845f;

constexpr size_t MiB = 1u << 20;
constexpr size_t WS_WIN = 0;
constexpr size_t WS_WOUT = 84 * MiB;
constexpr size_t WS_WUP = 116 * MiB;
constexpr size_t WS_WDN = 244 * MiB;
constexpr size_t WS_WMKV = 372 * MiB;
constexpr size_t WS_X = 388 * MiB;
constexpr size_t WS_XB = 452 * MiB;
constexpr size_t WS_PROJ = 484 * MiB;
constexpr size_t WS_MIX = 568 * MiB;
constexpr size_t WS_U = 600 * MiB;
constexpr size_t WS_ST = WS_U;
constexpr size_t WS_QD = WS_U + 64 * MiB;
constexpr size_t WS_KI = WS_U + 80 * MiB;
constexpr size_t WS_DILO = WS_U + 96 * MiB;
constexpr size_t WS_DILL = WS_U + 120 * MiB;
constexpr size_t WS_MEMB = 728 * MiB;
constexpr size_t WS_MEMKV = 729 * MiB;
constexpr size_t WS_SSQ = 731 * MiB;
constexpr size_t WS_DEC = 732 * MiB;
constexpr size_t WS_SSQM = 733 * MiB;
constexpr size_t WS_ST2 = 734 * MiB;
constexpr size_t WS_BAR = 798 * MiB;
constexpr size_t WS_XB2 = 800 * MiB;
constexpr size_t WS_MEMB2 = 832 * MiB;
constexpr size_t WS_WIN0 = 834 * MiB;
constexpr size_t WS_WMKV2 = 855 * MiB;
constexpr size_t WS_END = 871 * MiB;

constexpr int LDS_BYTES = 148992;
constexpr int LDS_MISC = 148736;

typedef __bf16 bf16x2_t __attribute__((ext_vector_type(2)));
__device__ __forceinline__ unsigned pk2(float lo, float hi) { bf16x2_t v = {(__bf16)lo, (__bf16)hi}; return __builtin_bit_cast(unsigned, v); }
__device__ __forceinline__ unsigned cvt_pk_bf16(float lo, float hi) { return pk2(lo, hi); }
__device__ __forceinline__ bf16_t f2bf(float f) { return (bf16_t)(pk2(f, 0.f) & 0xffffu); }
__device__ __forceinline__ float bf2f(bf16_t b) { return __uint_as_float(((unsigned)b) << 16); }
__device__ __forceinline__ float bflo(unsigned w) { return __uint_as_float(w << 16); }
__device__ __forceinline__ float bfhi(unsigned w) { return __uint_as_float(w & 0xffff0000u); }
__device__ __forceinline__ s16x4 tr4(const LAS unsigned char* p) { return __builtin_bit_cast(s16x4, __builtin_amdgcn_ds_read_tr16_b64_v4i16((LAS v4i16_t*)p)); }
__device__ __forceinline__ bf16x8 tr8(const LAS unsigned char* p0, const LAS unsigned char* p1) {
    const s16x4 a = tr4(p0), b = tr4(p1);
    return (bf16x8){a[0], a[1], a[2], a[3], b[0], b[1], b[2], b[3]};
}
__device__ __forceinline__ float fexp(float x) { return __builtin_amdgcn_exp2f(x * 1.4426950408889634f); }
__device__ __forceinline__ float flog(float x) { return __builtin_amdgcn_logf(x) * 0.6931471805599453f; }
__device__ __forceinline__ f32x4 mfma16(bf16x8 a, bf16x8 b, f32x4 c) { return __builtin_amdgcn_mfma_f32_16x16x32_bf16(a, b, c, 0, 0, 0); }
__device__ __forceinline__ float wave_sum(float v) {
#pragma unroll
    for (int o = 1; o < 64; o <<= 1) v += __shfl_xor(v, o);
    return v;
}


__device__ __forceinline__ int tid_op() { int t = threadIdx.x; asm volatile("" : "+v"(t)); return t; }
__device__ __forceinline__ int bid_op() { int b = blockIdx.x; asm volatile("" : "+s"(b)); return b; }

namespace pg8 {
#define PG8_LAS __attribute__((address_space(3)))
constexpr int BM = 256, BK = 64, HALF = 128, HTB = HALF * BK * 2, STAGE_BYTES = 8 * HTB, NXCD = 8, WGM = 8;
__host__ __device__ __forceinline__ int lds_byte(int r, int c) { const int st = (r >> 4) * 2 + (c >> 5), rr = r & 15, cc = c & 31, ob = rr * 64 + cc * 2; return st * 1024 + (ob ^ (((ob >> 9) & 1) << 5)); }
__host__ __device__ __forceinline__ void stage_rc(int b, int& R, int& C) { const int st = b / 1024, sb = b % 1024, swz = sb ^ (((sb >> 9) & 1) << 5); R = (st >> 1) * 16 + swz / 64; C = (st & 1) * 32 + (swz % 64) / 2; }
__host__ __device__ __forceinline__ int perm32(int rho) { const int n = rho >> 4, i = rho & 15; return 8 * (i >> 2) + 4 * n + (i & 3); }
struct Unit { int pm, pn, idx; };
struct Gemm { const bf16_t* A; const bf16_t* Bt; int M, N, K; };
struct StaticOrder {
    int nM, nN, nwg, G, c, n_extra, ex_pm, ex_pn0;
    __device__ __forceinline__ void init(int M, int N, int G_, int c_) { nM = M / BM; nN = N / BM; nwg = nM * nN; G = G_; c = c_; n_extra = 0; ex_pm = 0; ex_pn0 = 0; }
    __device__ __forceinline__ bool next(int i, Unit& u) const {
        const long L = (long)i * G + c; if (L >= nwg + n_extra) return false;
        u.idx = i;
        if (L >= nwg) { u.pm = ex_pm; u.pn = ex_pn0 + (int)(L - nwg); return true; }
        int wgid = (int)L; { const int q = nwg / NXCD, r = nwg % NXCD, xcd = wgid % NXCD, off = wgid / NXCD; wgid = (xcd < r ? xcd * (q + 1) : r * (q + 1) + (xcd - r) * q) + off; }
        const int nig = WGM * nN, gid = wgid / nig, fm = gid * WGM, gsz = (nM - fm) < WGM ? (nM - fm) : WGM;
        u.pm = fm + ((wgid % nig) % gsz); u.pn = (wgid % nig) / gsz; return true;
    }
};

struct EpiProj {
    static constexpr bool PERM = true;
    bf16_t* O; int ldc; const float* ssq; int act;
    bf16_t* O2; int ldc2; const float* ssq2; int alt_pm, alt_pn0; PG8_LAS float* rsq;
    __device__ __forceinline__ void operator()(const f32x4 (&acc)[2][2][4][2], const Unit& u, int wr, int wc, int fr, int fq) const {
        const bool alt = u.pm >= alt_pm;
        bf16_t* const O = alt ? O2 : this->O; const int ldc = alt ? ldc2 : this->ldc;
        const int row0 = (alt ? u.pm - alt_pm : u.pm) * BM + wr * 64 + fr, col0 = (alt ? u.pn - alt_pn0 : u.pn) * BM + wc * 32 + 8 * fq;
        const PG8_LAS float* rst = rsq + u.idx * BM + wr * 64 + fr;
#pragma unroll
        for (int ai = 0; ai < 2; ++ai)
#pragma unroll
            for (int m = 0; m < 4; ++m) {
                const int row = row0 + ai * HALF + m * 16;
                const float rs = rst[ai * HALF + m * 16];
                bf16_t* rowp = O + (size_t)row * ldc + col0;
#pragma unroll
                for (int bj = 0; bj < 2; ++bj) {
                    f32x4 v0 = acc[ai][bj][m][0] * rs, v1 = acc[ai][bj][m][1] * rs;
                    if (act) {
                        f32x4 r0, r1;
#pragma unroll
                        for (int j = 0; j < 4; ++j) { r0[j] = __builtin_amdgcn_fmed3f(v0[j], 0.f, 3.0e38f); r1[j] = __builtin_amdgcn_fmed3f(v1[j], 0.f, 3.0e38f); }
                        v0 = r0 * r0; v1 = r1 * r1;
                    }
                    u32x4 w; w.x = cvt_pk_bf16(v0[0], v0[1]); w.y = cvt_pk_bf16(v0[2], v0[3]); w.z = cvt_pk_bf16(v1[0], v1[1]); w.w = cvt_pk_bf16(v1[2], v1[3]);
                    *(u32x4*)(rowp + bj * HALF) = w;
                }
            }
    }
    __device__ __forceinline__ void fill_row_scales(const StaticOrder& S) const {
        const int tid = tid_op(), r = tid >> 1, hf = tid & 1;
        Unit u;
#pragma unroll 1
        for (int i = 0; S.next(i, u); ++i) {
            const bool alt = u.pm >= alt_pm;
            const float* sp = (alt ? ssq2 : ssq) + ((size_t)(alt ? u.pm - alt_pm : u.pm) * BM + r) * 32 + hf * 16;
            const f32x4 a0 = *(const f32x4*)sp, a1 = *(const f32x4*)(sp + 4), a2 = *(const f32x4*)(sp + 8), a3 = *(const f32x4*)(sp + 12);
            float s = (((a0[0] + a0[1]) + (a0[2] + a0[3])) + ((a1[0] + a1[1]) + (a1[2] + a1[3]))) + (((a2[0] + a2[1]) + (a2[2] + a2[3])) + ((a3[0] + a3[1]) + (a3[2] + a3[3])));
            s += __shfl_xor(s, 1);
            if (hf == 0) rsq[i * BM + r] = __builtin_amdgcn_rsqf(s * (1.0f / 2048.0f) + EPS);
        }
        __syncthreads();
    }
};
struct EpiResid {
    static constexpr bool PERM = false;
    const float* Xin; float* X; bf16_t* XB; float* ssq;
    __device__ __forceinline__ void operator()(const f32x4 (&acc)[2][2][4][2], const Unit& u, int wr, int wc, int fr, int fq) const {
        const int row0 = u.pm * BM + wr * 64 + fr, col0 = u.pn * BM + wc * 32 + 4 * fq;
        f32x4 xc[2][2], xn[2][2];
#pragma unroll
        for (int bj = 0; bj < 2; ++bj)
#pragma unroll
            for (int n = 0; n < 2; ++n) xc[bj][n] = *(const f32x4*)(Xin + (size_t)row0 * DM + col0 + bj * HALF + n * 16);
#pragma unroll
        for (int k = 0; k < 8; ++k) {
            const int ai = k >> 2, m = k & 3;
            const int row = row0 + ai * HALF + m * 16;
            const size_t off = (size_t)row * DM + col0;
            if (k < 7) {
                const size_t offn = (size_t)(row0 + ((k + 1) >> 2) * HALF + ((k + 1) & 3) * 16) * DM + col0;
#pragma unroll
                for (int bj = 0; bj < 2; ++bj)
#pragma unroll
                    for (int n = 0; n < 2; ++n) xn[bj][n] = *(const f32x4*)(Xin + offn + bj * HALF + n * 16);
            }
            float sq = 0.f;
#pragma unroll
            for (int bj = 0; bj < 2; ++bj)
#pragma unroll
                for (int n = 0; n < 2; ++n) {
                    const size_t o = off + bj * HALF + n * 16;
                    const f32x4 xv = xc[bj][n] + acc[ai][bj][m][n];
                    *(f32x4*)(X + o) = xv;
                    u32x2 w; w.x = cvt_pk_bf16(xv[0], xv[1]); w.y = cvt_pk_bf16(xv[2], xv[3]);
                    *(u32x2*)(XB + o) = w;
                    sq += (xv[0] * xv[0] + xv[1] * xv[1]) + (xv[2] * xv[2] + xv[3] * xv[3]);
                }
            sq += __shfl_xor(sq, 16); sq += __shfl_xor(sq, 32);
            if (fq == 0) ssq[(size_t)row * 32 + u.pn * 4 + wc] = sq;
#pragma unroll
            for (int bj = 0; bj < 2; ++bj)
#pragma unroll
                for (int n = 0; n < 2; ++n) xc[bj][n] = xn[bj][n];
        }
    }
};

template <class Epi>
__device__ __forceinline__ void gemm_phase(PG8_LAS unsigned char* lds, const Gemm g, const StaticOrder& S, const Epi& E) {
    const int tid = tid_op(), wid = __builtin_amdgcn_readfirstlane(tid >> 6), lane = tid & 63, wr = wid >> 2, wc = wid & 3, fr = lane & 15, fq = lane >> 4;
    const int K = g.K, nt = K / BK;
    unsigned voffA[2], voffB[2];
#pragma unroll
    for (int i = 0; i < 2; ++i) { int R, C; stage_rc(tid * 16 + i * 8192, R, C); const int Rb = Epi::PERM ? ((R & ~31) + perm32(R & 31)) : R;
        voffA[i] = (unsigned)(R * K + C) * 2u; voffB[i] = (unsigned)(Rb * K + C) * 2u; }
    const size_t kstep = (size_t)(BK * 2);
    const size_t hstep = (size_t)HALF * K * 2;
    const size_t tstep = 2 * hstep;
    const unsigned ldsw = (unsigned)wid * 1024u;
    const int aoff = lds_byte(wr * 64 + fr, fq * 8), boff = lds_byte(wc * 32 + fr, fq * 8);
#define PG8_SA(b, h) (((b) * 2 + (h)) * HTB)
#define PG8_SB(b, h) ((4 + (b) * 2 + (h)) * HTB)
#define PG8_STAGE(bufoff, gbase, voff) do { _Pragma("unroll") for (int _i = 0; _i < 2; ++_i) \
        __builtin_amdgcn_global_load_lds((const unsigned*)((const char*)(gbase) + (voff)[_i]), (PG8_LAS unsigned*)(lds + (bufoff) + ldsw + _i * 8192), 16, 0, 0); } while (0)
#define PG8_LDA(dst, b, h) do { _Pragma("unroll") for (int m = 0; m < 4; ++m) _Pragma("unroll") for (int k = 0; k < 2; ++k) dst[m][k] = *(const PG8_LAS bf16x8*)(lds + PG8_SA(b, h) + aoff + m * 2048 + k * 1024); } while (0)
#define PG8_LDB(dst, b, h) do { _Pragma("unroll") for (int n = 0; n < 2; ++n) _Pragma("unroll") for (int k = 0; k < 2; ++k) dst[n][k] = *(const PG8_LAS bf16x8*)(lds + PG8_SB(b, h) + boff + n * 2048 + k * 1024); } while (0)
#define PG8_MMA(ai, bj, At, Bt) do { __builtin_amdgcn_s_setprio(1); _Pragma("unroll") for (int m = 0; m < 4; ++m) _Pragma("unroll") for (int n = 0; n < 2; ++n) _Pragma("unroll") for (int k = 0; k < 2; ++k) \
        acc[ai][bj][m][n] = __builtin_amdgcn_mfma_f32_16x16x32_bf16(Bt[n][k], At[m][k], acc[ai][bj][m][n], 0, 0, 0); __builtin_amdgcn_s_setprio(0); } while (0)
#define PG8_WAIT_V(n) asm volatile("s_waitcnt vmcnt(" #n ")" ::: "memory")
#define PG8_WAIT_L(n) asm volatile("s_waitcnt lgkmcnt(" #n ")" ::: "memory")
#define PG8_BAR __builtin_amdgcn_s_barrier()
#define PG8_SCHED __builtin_amdgcn_sched_barrier(0)
    Unit cur, nxt; int ui = 0;
    if (!S.next(0, cur)) return;
    f32x4 acc[2][2][4][2];
#pragma unroll
    for (int a = 0; a < 2; ++a)
#pragma unroll
        for (int b = 0; b < 2; ++b)
#pragma unroll
            for (int m = 0; m < 4; ++m)
#pragma unroll
                for (int n = 0; n < 2; ++n) acc[a][b][m][n] = (f32x4){0.f, 0.f, 0.f, 0.f};
    bf16x8 At[4][2], B0[2][2], B1[2][2];
    const char* cA = (const char*)g.A + (size_t)cur.pm * tstep; const char* cB = (const char*)g.Bt + (size_t)cur.pn * tstep;
    PG8_STAGE(PG8_SB(0, 0), cB, voffB); PG8_STAGE(PG8_SB(0, 1), cB + hstep, voffB); PG8_STAGE(PG8_SA(0, 0), cA, voffA); PG8_STAGE(PG8_SA(0, 1), cA + hstep, voffA);
    if (wr == 1) PG8_BAR;
    PG8_WAIT_V(2); PG8_BAR;
    PG8_STAGE(PG8_SB(1, 0), cB + kstep, voffB); PG8_STAGE(PG8_SA(1, 0), cA + kstep, voffA); PG8_STAGE(PG8_SB(1, 1), cB + hstep + kstep, voffB);
    PG8_WAIT_V(6); PG8_BAR;
    for (;;) {
        const bool has_next = S.next(ui + 1, nxt);
        const char* nA = has_next ? (const char*)g.A + (size_t)nxt.pm * tstep : cA; const char* nB = has_next ? (const char*)g.Bt + (size_t)nxt.pn * tstep : cB;
        for (int t = 0; t < nt; t += 2) {
            const bool last = (t == nt - 2);
            const char* a1 = cA + (size_t)(t + 1) * kstep;
            const char* a2 = last ? nA : cA + (size_t)(t + 2) * kstep; const char* b2 = last ? nB : cB + (size_t)(t + 2) * kstep;
            const char* a3 = a2 + kstep; const char* b3 = b2 + kstep;
            PG8_LDB(B0, 0, 0); PG8_LDB(B1, 0, 1); PG8_SCHED; PG8_LDA(At, 0, 0); PG8_STAGE(PG8_SA(1, 1), a1 + hstep, voffA);
            PG8_WAIT_V(8); PG8_WAIT_L(0); PG8_BAR; PG8_MMA(0, 0, At, B0); PG8_MMA(0, 1, At, B1); PG8_BAR; PG8_SCHED;
            PG8_LDA(At, 0, 1); PG8_STAGE(PG8_SB(0, 0), b2, voffB); PG8_STAGE(PG8_SB(0, 1), b2 + hstep, voffB); PG8_STAGE(PG8_SA(0, 0), a2, voffA);
            PG8_WAIT_V(8); PG8_WAIT_L(0); PG8_BAR; PG8_MMA(1, 0, At, B0); PG8_MMA(1, 1, At, B1); PG8_BAR; PG8_SCHED;
            PG8_LDB(B0, 1, 0); PG8_LDB(B1, 1, 1); PG8_SCHED; PG8_LDA(At, 1, 0); PG8_STAGE(PG8_SA(0, 1), a2 + hstep, voffA);
            PG8_WAIT_V(8); PG8_WAIT_L(0); PG8_BAR; PG8_MMA(0, 0, At, B0); PG8_MMA(0, 1, At, B1); PG8_BAR; PG8_SCHED;
            PG8_LDA(At, 1, 1); PG8_STAGE(PG8_SB(1, 0), b3, voffB); PG8_STAGE(PG8_SB(1, 1), b3 + hstep, voffB); PG8_STAGE(PG8_SA(1, 0), a3, voffA);
            PG8_WAIT_V(8); PG8_WAIT_L(0); PG8_BAR; PG8_MMA(1, 0, At, B0); PG8_MMA(1, 1, At, B1); PG8_BAR; PG8_SCHED;
        }
        if (wr == 0) PG8_BAR;
        E(acc, cur, wr, wc, fr, fq);
        if (!has_next) break;
#pragma unroll
        for (int a = 0; a < 2; ++a)
#pragma unroll
            for (int b = 0; b < 2; ++b)
#pragma unroll
                for (int m = 0; m < 4; ++m)
#pragma unroll
                    for (int n = 0; n < 2; ++n) acc[a][b][m][n] = (f32x4){0.f, 0.f, 0.f, 0.f};
        cur = nxt; cA = nA; cB = nB; ++ui;
        if (wr == 1) PG8_BAR;
    }
    PG8_WAIT_V(0);
    PG8_BAR;
#undef PG8_SA
#undef PG8_SB
#undef PG8_STAGE
#undef PG8_LDA
#undef PG8_LDB
#undef PG8_MMA
#undef PG8_WAIT_V
#undef PG8_WAIT_L
#undef PG8_BAR
#undef PG8_SCHED
}
}

typedef __attribute__((address_space(1))) unsigned gu32;
#define XB_TMO      128
#define XB_XCNT(j)  (256  + 64 * (j))
#define XB_XSUB(j)  (1280 + 64 * (j))
#define XB_XGEN(j)  (2304 + 64 * (j))
#define XB_TOP      3328
#define XB_TOPGEN   3392
#define XCD_BAR_WORDS 3456
#define XB_SPIN_CAP (1u << 18)

__device__ __forceinline__ unsigned xb_ld(unsigned* p)              { return __hip_atomic_load(p, __ATOMIC_RELAXED, __HIP_MEMORY_SCOPE_AGENT); }
__device__ __forceinline__ unsigned xb_add(unsigned* p, unsigned v) { return __hip_atomic_fetch_add(p, v, __ATOMIC_RELAXED, __HIP_MEMORY_SCOPE_AGENT); }
__device__ __forceinline__ unsigned xb_xcc_id() { return (unsigned)__builtin_amdgcn_s_getreg((3 << 11) | 20) & 0xFu; }
#define XB_SPIN(cond, bar) do { unsigned _sp = 0; while (cond) { __builtin_amdgcn_s_sleep(1); \
    if ((++_sp & 255u) == 0u) { if (xb_ld(&(bar)[XB_TMO])) break; if (_sp > XB_SPIN_CAP) { atomicAdd(&(bar)[XB_TMO], 1u); break; } } } } while (0)

struct XcdBarrier {
    unsigned* bar; unsigned x;
    volatile LAS unsigned* st;
};

__device__ __forceinline__ XcdBarrier xcd_barrier_post(unsigned* bar, volatile LAS unsigned* st) {
    XcdBarrier b; b.bar = bar; b.x = xb_xcc_id(); b.st = st;
    if (threadIdx.x == 0) (void)xb_add(&bar[XB_XCNT(b.x)], 1u);
    return b;
}
__device__ __forceinline__ void xcd_barrier_complete(unsigned* bar, unsigned x, unsigned& nloc, unsigned& nx) {
    const unsigned G = gridDim.x * gridDim.y * gridDim.z;
    unsigned sum, cnt, mine, sp = 0u;
    for (;;) {
        sum = 0u; cnt = 0u; mine = 0u;
#pragma unroll
        for (unsigned j = 0; j < 16; ++j) { const unsigned c = xb_ld(&bar[XB_XCNT(j)]); sum += c; cnt += (c > 0u) ? 1u : 0u; mine = (j == x) ? c : mine; }
        if (sum == G) break;
        __builtin_amdgcn_s_sleep(1);
        if ((++sp & 255u) == 0u) { if (xb_ld(&bar[XB_TMO])) break; if (sp > XB_SPIN_CAP) { atomicAdd(&bar[XB_TMO], 1u); break; } }
    }
    nloc = mine > 0u ? mine : 1u; nx = cnt > 0u ? cnt : 1u;
}

__device__ __forceinline__ void xcd_barrier(const XcdBarrier& b) {
    asm volatile("s_waitcnt vmcnt(0)" ::: "memory");
    __syncthreads();
    if (threadIdx.x == 0) {
        unsigned* bar = b.bar;
        __builtin_amdgcn_s_waitcnt(0);
        unsigned nloc = b.st[0], nx = b.st[1];
        if (nloc == 0u) { xcd_barrier_complete(bar, b.x, nloc, nx); b.st[0] = nloc; b.st[1] = nx; }
        const unsigned old = xb_add(&bar[XB_XSUB(b.x)], 1u);
        const unsigned gen = old / nloc;
        if (old + 1u == (gen + 1u) * nloc) {
            __builtin_amdgcn_fence(__ATOMIC_RELEASE, "agent");
            asm volatile("s_waitcnt vmcnt(0)" ::: "memory");
            const unsigned og = xb_add(&bar[XB_TOP], 1u);
            const unsigned tg = og / nx;
            if (og + 1u == (tg + 1u) * nx) xb_add(&bar[XB_TOPGEN], 1u);
            else XB_SPIN(xb_ld(&bar[XB_TOPGEN]) == tg, bar);
            __builtin_amdgcn_fence(__ATOMIC_ACQUIRE, "agent");
            xb_add(&bar[XB_XGEN(b.x)], 1u);
            asm volatile("s_waitcnt vmcnt(0)" ::: "memory");
        } else {
            XB_SPIN(xb_ld(&bar[XB_XGEN(b.x)]) == gen, bar);
            __builtin_amdgcn_fence(__ATOMIC_ACQUIRE, "agent");
            asm volatile("s_waitcnt vmcnt(0)" ::: "memory");
        }
    }
    __syncthreads();
}


struct Args { const float* in[19]; float* out; unsigned char* ws; int ph_lo, ph_hi; };
enum { I_X = 0, I_MEM, I_NORM_MIX, I_W_IN, I_UP_F, I_BIAS_F, I_UP_B, I_BIAS_B, I_GLA_NORM, I_REL, I_DIL_NORM, I_MEM_NORM, I_W_MKV, I_MEM_ONORM, I_W_OUT, I_NORM_MLP, I_W_UP, I_W_DOWN, I_NORM_FINAL };
typedef const __attribute__((address_space(4))) Args* ArgsP;
constexpr int NPHASE = 1 + 7 * DEPTH + 1;

constexpr int TS = 272;
struct TrJob { const float* src; const float* gain; bf16_t* dst; int K, N, mode, kb, nb4, nblk; bool valid; };
__device__ __forceinline__ int colblk_map(int mode, int sb) { return mode == 0 ? sb : (sb < 96 ? sb : (sb == 96 ? 160 : sb - 1)); }
__device__ __forceinline__ TrJob tr_job(ArgsP a, int it) {
    TrJob j; j.valid = true; j.gain = nullptr; j.mode = 0;
    int r = it, l, nbn;
    bf16_t* ws16;
    if (r < 4 * 656) { l = r / 656; r -= l * 656; j.K = DM; j.N = NIN_SRC; j.src = a->in[I_W_IN] + (size_t)l * DM * NIN_SRC; j.gain = a->in[I_NORM_MIX] + l * DM; ws16 = l == 0 ? (bf16_t*)(a->ws + WS_WIN0) : (bf16_t*)(a->ws + WS_WIN) + (size_t)l * NIN * DM; j.mode = 1; nbn = 41; }
    else if ((r -= 4 * 656) < 4 * 256) { l = r / 256; r -= l * 256; j.K = DM; j.N = DM; j.src = a->in[I_W_OUT] + (size_t)l * DM * DM; ws16 = (bf16_t*)(a->ws + WS_WOUT) + (size_t)l * DM * DM; nbn = 16; }
    else if ((r -= 4 * 256) < 4 * 1024) { l = r / 1024; r -= l * 1024; j.K = DM; j.N = DFF; j.src = a->in[I_W_UP] + (size_t)l * DM * DFF; j.gain = a->in[I_NORM_MLP] + l * DM; ws16 = (bf16_t*)(a->ws + WS_WUP) + (size_t)l * DFF * DM; nbn = 64; }
    else if ((r -= 4 * 1024) < 4 * 1024) { l = r / 1024; r -= l * 1024; j.K = DFF; j.N = DM; j.src = a->in[I_W_DOWN] + (size_t)l * DFF * DM; ws16 = (bf16_t*)(a->ws + WS_WDN) + (size_t)l * DM * DFF; nbn = 16; }
    else if ((r -= 4 * 1024) < 4 * 128) { l = r / 128; r -= l * 128; j.K = DM; j.N = 1024; j.src = a->in[I_W_MKV] + (size_t)l * DM * 1024; j.gain = a->in[I_MEM_NORM] + l * DM; ws16 = (bf16_t*)(a->ws + WS_WMKV2) + (size_t)l * 1024 * DM; nbn = 8; }
    else { j.valid = false; j.K = 0; j.N = 0; j.src = nullptr; ws16 = nullptr; nbn = 1; r = 0; }
    j.dst = ws16; j.kb = r / nbn; j.nb4 = r % nbn; j.nblk = j.N / 32;
    return j;
}
constexpr int N_TR_ITEMS = 4 * (656 + 256 + 1024 + 1024 + 128);
__device__ __forceinline__ void tr_load(const TrJob& j, f32x4 (&v)[8]) {
    const int tid = tid_op(), cq = tid & 31, k0 = tid >> 5;
    const bool ok = j.valid && (4 * j.nb4 + (cq >> 3)) < j.nblk;
#pragma unroll
    for (int i = 0; i < 8; ++i) {
        const int k = 128 * j.kb + 16 * i + k0;
        if (ok) { const f32x4 x = *(const f32x4*)(j.src + (size_t)k * j.N + 128 * j.nb4 + 4 * cq); const float g = j.gain ? j.gain[k] : 1.0f; v[i] = x * g; }
        else v[i] = (f32x4){0.f, 0.f, 0.f, 0.f};
    }
}
__device__ __forceinline__ void tr_store(const TrJob& j, const f32x4 (&v)[8], LAS unsigned char* lds) {
    const int tid = tid_op(), cq = tid & 31, k0 = tid >> 5, lane = tid & 63, w = __builtin_amdgcn_readfirstlane(tid >> 6), g = lane >> 4, i = lane & 15;
#pragma unroll
    for (int q = 0; q < 8; ++q) { u32x2 p; p.x = pk2(v[q][0], v[q][1]); p.y = pk2(v[q][2], v[q][3]); *(LAS u32x2*)(lds + (16 * q + k0) * TS + 8 * cq) = p; }
    __syncthreads();
    const int kq = w & 3;
#pragma unroll
    for (int c = 0; c < 4; ++c) {
        const int nq = (w >> 2) * 4 + c, sb = 4 * j.nb4 + (nq >> 1);
        if (sb < j.nblk) {
            const LAS unsigned char* p0 = lds + (32 * kq + 8 * g + (i >> 2)) * TS + (16 * nq + 4 * (i & 3)) * 2;
            const bf16x8 t = tr8(p0, p0 + 4 * TS);
            const int drow = colblk_map(j.mode, sb) * 32 + (nq & 1) * 16 + i;
            *(bf16x8*)(j.dst + (size_t)drow * j.K + 128 * j.kb + 32 * kq + 8 * g) = t;
        }
    }
    __syncthreads();
}
__device__ __forceinline__ void prep_row(const float* src, float* dstf, bf16_t* dstb, float* ssq, int lane) {
    float s = 0.f;
#pragma unroll
    for (int jj = 0; jj < 8; ++jj) {
        const f32x4 v = *((const f32x4*)src + 64 * jj + lane);
        if (dstf) *((f32x4*)dstf + 64 * jj + lane) = v;
        u32x2 p; p.x = pk2(v[0], v[1]); p.y = pk2(v[2], v[3]);
        *((u32x2*)dstb + 64 * jj + lane) = p;
        s += (v[0] * v[0] + v[1] * v[1]) + (v[2] * v[2] + v[3] * v[3]);
    }
    s = wave_sum(s);
    if (lane < 32) ssq[lane] = lane == 0 ? s : 0.f;
}
__device__ __forceinline__ void phase_prep(ArgsP a, LAS unsigned char* lds) {
    const int tid = tid_op(), lane = tid & 63, w = __builtin_amdgcn_readfirstlane(tid >> 6);
    const int G = gridDim.x, gw = bid_op() * 8 + w, NGW = G * 8;
    for (int r = gw; r < SEQ; r += NGW) prep_row(a->in[I_X] + (size_t)r * DM, nullptr, (bf16_t*)(a->ws + WS_XB2) + (size_t)r * DM, (float*)(a->ws + WS_SSQ) + (size_t)r * 32, lane);
    for (int r = gw; r < MEML; r += NGW) prep_row(a->in[I_MEM] + (size_t)r * DM, nullptr, (bf16_t*)(a->ws + WS_MEMB2) + (size_t)r * DM, (float*)(a->ws + WS_SSQM) + (size_t)r * 32, lane);
    { const size_t per = (size_t)(NIN - NIN_SRC) * DM * 2 / 16;
      for (size_t c = (size_t)bid_op() * 512 + tid; c < 4 * per; c += (size_t)G * 512) { const size_t l = c / per, o = c % per;
          *(u32x4*)(a->ws + (l == 0 ? WS_WIN0 : WS_WIN + l * NIN * DM * 2) + (size_t)NIN_SRC * DM * 2 + o * 16) = (u32x4){0u, 0u, 0u, 0u}; } }
    f32x4 v[8];
    int it = bid_op();
    TrJob cur = tr_job(a, it);
    if (it < N_TR_ITEMS) tr_load(cur, v);
    while (it < N_TR_ITEMS) {
        const int nit = it + G;
        const int cq = tid & 31, k0 = tid >> 5;
#pragma unroll
        for (int q = 0; q < 8; ++q) { u32x2 p; p.x = pk2(v[q][0], v[q][1]); p.y = pk2(v[q][2], v[q][3]); *(LAS u32x2*)(lds + (16 * q + k0) * TS + 8 * cq) = p; }
        __syncthreads();
        const TrJob nxt = tr_job(a, nit < N_TR_ITEMS ? nit : 0);
        if (nit < N_TR_ITEMS) tr_load(nxt, v);
        { const int g = lane >> 4, i = lane & 15, kq = w & 3;
#pragma unroll
          for (int c = 0; c < 4; ++c) {
              const int nq = (w >> 2) * 4 + c, sb = 4 * cur.nb4 + (nq >> 1);
              if (sb < cur.nblk) {
                  const LAS unsigned char* p0 = lds + (32 * kq + 8 * g + (i >> 2)) * TS + (16 * nq + 4 * (i & 3)) * 2;
                  const bf16x8 t = tr8(p0, p0 + 4 * TS);
                  const int drow = colblk_map(cur.mode, sb) * 32 + (nq & 1) * 16 + i;
                  *(bf16x8*)(cur.dst + (size_t)drow * cur.K + 128 * cur.kb + 32 * kq + 8 * g) = t;
              }
          } }
        __syncthreads();
        cur = nxt; it = nit;
    }
}

constexpr int AST = 272;
template <int NTS, int NT, bool MASK>
__device__ __forceinline__ void attn_core(const LAS unsigned char* Kb, const LAS unsigned char* Vb, const bf16x8 (&qf)[4], const LAS float* tabp, bool edge, int klo, int khi,
                                          f32x4 (&o)[8], float& mrow, float& den) {
    const int lane = tid_op() & 63, g = lane >> 4, i = lane & 15;
    f32x4 s[NTS];
#pragma unroll
    for (int t = 0; t < NTS; ++t) {
        s[t] = (f32x4){0.f, 0.f, 0.f, 0.f};
#pragma unroll
        for (int ks = 0; ks < 4; ++ks) {
            const bf16x8 kf = *(const LAS bf16x8*)(Kb + (16 * t + i) * AST + (32 * ks + 8 * g) * 2);
            s[t] = mfma16(kf, qf[ks], s[t]);
        }
    }
    constexpr float C2 = QSCALE * 1.4426950408889634f;
    float mx = -3.0e38f;
#pragma unroll
    for (int t = 0; t < NTS; ++t) {
        f32x2 lo = (f32x2){s[t][0], s[t][1]}, hi = (f32x2){s[t][2], s[t][3]};
        if (MASK) { const f32x2 tl = (f32x2){tabp[16 * t], tabp[16 * t + 1]}, th = (f32x2){tabp[16 * t + 2], tabp[16 * t + 3]}; lo = lo * C2 + tl; hi = hi * C2 + th; }
        else { lo = lo * C2; hi = hi * C2; }
        s[t] = (f32x4){lo.x, lo.y, hi.x, hi.y};
        mx = fmaxf(fmaxf(mx, lo.x), fmaxf(lo.y, fmaxf(hi.x, hi.y)));
    }
    if (MASK && edge) {
        mx = -3.0e38f;
#pragma unroll
        for (int t = 0; t < NTS; ++t)
#pragma unroll
            for (int r = 0; r < 4; ++r) { const int kq = 16 * t + r; const float v = (kq >= klo && kq < khi) ? s[t][r] : -1.0e30f; s[t][r] = v; mx = fmaxf(mx, v); }
    }
    mx = fmaxf(mx, __shfl_xor(mx, 16)); mx = fmaxf(mx, __shfl_xor(mx, 32));
    f32x2 sum2 = (f32x2){0.f, 0.f};
    const f32x2 nmx = (f32x2){-mx, -mx};
#pragma unroll
    for (int t = 0; t < NTS; ++t) {
        const f32x2 dl = (f32x2){s[t][0], s[t][1]} + nmx, dh = (f32x2){s[t][2], s[t][3]} + nmx;
        const f32x2 pl = (f32x2){__builtin_amdgcn_exp2f(dl.x), __builtin_amdgcn_exp2f(dl.y)}, ph = (f32x2){__builtin_amdgcn_exp2f(dh.x), __builtin_amdgcn_exp2f(dh.y)};
        s[t] = (f32x4){pl.x, pl.y, ph.x, ph.y};
        sum2 = sum2 + pl; sum2 = sum2 + ph;
    }
    float sum = sum2.x + sum2.y;
    sum += __shfl_xor(sum, 16); sum += __shfl_xor(sum, 32);
#pragma unroll
    for (int et = 0; et < 8; ++et) o[et] = (f32x4){0.f, 0.f, 0.f, 0.f};
#pragma unroll
    for (int kk = 0; kk < NT / 2; ++kk) {
        u32x4 pw; pw.x = pk2(s[2 * kk][0], s[2 * kk][1]); pw.y = pk2(s[2 * kk][2], s[2 * kk][3]);
        if (2 * kk + 1 < NTS) { pw.z = pk2(s[2 * kk + 1 < NTS ? 2 * kk + 1 : 0][0], s[2 * kk + 1 < NTS ? 2 * kk + 1 : 0][1]); pw.w = pk2(s[2 * kk + 1 < NTS ? 2 * kk + 1 : 0][2], s[2 * kk + 1 < NTS ? 2 * kk + 1 : 0][3]); }
        else { pw.z = 0u; pw.w = 0u; }
        const bf16x8 pf = __builtin_bit_cast(bf16x8, pw);
#pragma unroll
        for (int et = 0; et < 8; ++et) {
            const LAS unsigned char* p0 = Vb + (32 * kk + 4 * g + (i >> 2)) * AST + (16 * et + 4 * (i & 3)) * 2;
            const bf16x8 vf = tr8(p0, p0 + 16 * AST);
            o[et] = mfma16(vf, pf, o[et]);
        }
    }
    mrow = mx; den = sum;
}

struct DilGeom { int pb, h, r, dsh, d, lsub, npairs, rr, p, tq0, tk0; };
__device__ __forceinline__ DilGeom dil_geom(int item) {
    DilGeom q; q.pb = item & 63; q.h = (item >> 6) & 3; q.r = item >> 8; q.dsh = 2 * q.r; q.d = 1 << q.dsh; q.lsub = SEQ >> q.dsh; q.npairs = 64 >> q.dsh;
    q.rr = q.pb / q.npairs; q.p = q.pb % q.npairs; q.tq0 = 128 * q.p; q.tk0 = 128 * q.p - 64; return q;
}
constexpr int DIL_TAB = 2 * 272 * AST;
__device__ __forceinline__ void dil_load(ArgsP a, int item, u32x4 (&kr)[8], u32x4 (&vr)[8]) {
    const int tid = tid_op(); const DilGeom q = dil_geom(item);
    const bf16_t* proj = (const bf16_t*)(a->ws + WS_PROJ);
#pragma unroll
    for (int j = 0; j < 8; ++j) {
        const int c = tid + 512 * j, ki = c >> 4, ch = c & 15, t = q.tk0 + ki;
        kr[j] = (u32x4){0u, 0u, 0u, 0u}; vr[j] = kr[j];
        if (t >= 0 && t < q.lsub) { const size_t pos = ((size_t)t << q.dsh) + q.rr; const bf16_t* row = proj + pos * NIN + q.h * 128 + 8 * ch; kr[j] = *(const u32x4*)(row + DKo); vr[j] = *(const u32x4*)(row + DVo); }
    }
}
__device__ __forceinline__ void dil_store(ArgsP a, int item, const u32x4 (&kr)[8], const u32x4 (&vr)[8], LAS unsigned char* lds) {
    const int tid = tid_op(); const DilGeom q = dil_geom(item);
    LAS unsigned char* Ks = lds; LAS unsigned char* Vs = lds + 272 * AST; LAS float* tab = (LAS float*)(lds + DIL_TAB);
#pragma unroll
    for (int j = 0; j < 8; ++j) { const int c = tid + 512 * j, ki = c >> 4, ch = c & 15; *(LAS u32x4*)(Ks + ki * AST + 16 * ch) = kr[j]; *(LAS u32x4*)(Vs + ki * AST + 16 * ch) = vr[j]; }
    if (tid < 256) { const int ki = 256 + (tid >> 4), ch = tid & 15; *(LAS u32x4*)(Ks + ki * AST + 16 * ch) = (u32x4){0u, 0u, 0u, 0u}; *(LAS u32x4*)(Vs + ki * AST + 16 * ch) = (u32x4){0u, 0u, 0u, 0u}; }
    if (tid >= 256 && tid < 448) {
        const int m = tid - 256, rel = m - 79; float v = -1.0e30f;
        if (rel >= -64 && rel <= 64) {
            const int n = (rel < 0 ? -rel : rel) * q.d;
            const int large = 8 + (n >= 15) + (n >= 27) + (n >= 50) + (n >= 91) + (n >= 166) + (n >= 305) + (n >= 559);
            const int bucket = (rel > 0 ? 16 : 0) + (n < 8 ? n : large);
            v = a->in[I_REL][bucket * 4 + q.h] * 1.4426950408889634f;
        }
        tab[m] = v;
    }
}
__device__ __forceinline__ void dil_compute(ArgsP a, int item, LAS unsigned char* lds) {
    const int tid = tid_op(), lane = tid & 63, w = __builtin_amdgcn_readfirstlane(tid >> 6), g = lane >> 4, i = lane & 15;
    const DilGeom q = dil_geom(item);
    const bf16_t* proj = (const bf16_t*)(a->ws + WS_PROJ);
    const LAS unsigned char* Ks = lds; const LAS unsigned char* Vs = lds + 272 * AST; const LAS float* tab = (const LAS float*)(lds + DIL_TAB);
    bf16x8 qf[4];
    const size_t qpos = ((size_t)(q.tq0 + 16 * w + i) << q.dsh) + q.rr;
#pragma unroll
    for (int ks = 0; ks < 4; ++ks) qf[ks] = *(const bf16x8*)(proj + qpos * NIN + DQ + q.h * 128 + 32 * ks + 8 * g);
    const bool edge = (q.p == 0) || (q.p == q.npairs - 1);
    const int kbase = q.tk0 + 16 * w + 4 * g;
    const int klo = -kbase, khi = q.lsub - kbase;
    f32x4 o[8]; float m, den;
    attn_core<9, 10, true>(Ks + 16 * w * AST, Vs + 16 * w * AST, qf, tab + (4 * g - i + 15), edge, klo, khi, o, m, den);
    const float inv = 1.0f / den;
    bf16_t* dst = (bf16_t*)(a->ws + WS_DILO) + ((size_t)q.r * SEQ + qpos) * 512 + q.h * 128 + 4 * g;
#pragma unroll
    for (int et = 0; et < 8; ++et) { u32x2 pv; pv.x = pk2(o[et][0] * inv, o[et][1] * inv); pv.y = pk2(o[et][2] * inv, o[et][3] * inv); *(u32x2*)(dst + 16 * et) = pv; }
    if (g == 0) ((float*)(a->ws + WS_DILL))[((size_t)q.r * SEQ + qpos) * 4 + q.h] = m * 0.6931471805599453f + logf(den);
}
__device__ __forceinline__ int dil_items(ArgsP a, int d0, int stride, LAS unsigned char* lds) {
    u32x4 kr[8], vr[8];
    int d = d0;
    if (d < 768) dil_load(a, d, kr, vr);
    while (d < 768) {
        dil_store(a, d, kr, vr, lds);
        __syncthreads();
        const int nd = d + stride;
        if (nd < 768) dil_load(a, nd, kr, vr);
        dil_compute(a, d, lds);
        __syncthreads();
        d = nd;
    }
    return d;
}

__device__ __forceinline__ void mem_item(ArgsP a, int layer, int item, LAS unsigned char* lds) {
    const int tid = tid_op(), lane = tid & 63, w = __builtin_amdgcn_readfirstlane(tid >> 6), g = lane >> 4, i = lane & 15;
    const int h = item & 3, qb = item >> 2;
    const bf16_t* proj = (const bf16_t*)(a->ws + WS_PROJ);
    const bf16_t* mkv = (const bf16_t*)(a->ws + WS_MEMKV);
    LAS unsigned char* Ks = lds; LAS unsigned char* Vs = lds + 272 * AST;
    for (int c = tid; c < 256 * 16; c += 512) {
        const int ki = c >> 4, ch = c & 15;
        const bf16_t* row = mkv + (size_t)ki * 4096 + layer * 1024 + h * 128 + 8 * ch;
        *(LAS u32x4*)(Ks + ki * AST + 16 * ch) = *(const u32x4*)row; *(LAS u32x4*)(Vs + ki * AST + 16 * ch) = *(const u32x4*)(row + 512);
    }
    __syncthreads();
    bf16x8 qf[4];
    const size_t qpos = (size_t)qb * 128 + 16 * w + i;
#pragma unroll
    for (int ks = 0; ks < 4; ++ks) qf[ks] = *(const bf16x8*)(proj + qpos * NIN + MQ + h * 128 + 32 * ks + 8 * g);
    f32x4 o[8]; float m, den;
    attn_core<16, 16, false>(Ks, Vs, qf, nullptr, false, 0, 0, o, m, den);
    const float inv = 1.0f / den;
    float ss = 0.f;
#pragma unroll
    for (int et = 0; et < 8; ++et) { o[et] = o[et] * inv; ss += (o[et][0] * o[et][0] + o[et][1] * o[et][1]) + (o[et][2] * o[et][2] + o[et][3] * o[et][3]); }
    ss += __shfl_xor(ss, 16); ss += __shfl_xor(ss, 32);
    const float rs = __builtin_amdgcn_rsqf(ss * (1.0f / 128.0f) + EPS);
    const float* gn = a->in[I_MEM_ONORM] + layer * 512 + h * 128 + 4 * g;
    bf16_t* dst = (bf16_t*)(a->ws + WS_MIX) + qpos * DM + 1536 + h * 128 + 4 * g;
#pragma unroll
    for (int et = 0; et < 8; ++et) { const f32x4 gv = *(const f32x4*)(gn + 16 * et); const f32x4 v = o[et] * rs * gv; u32x2 pv; pv.x = pk2(v[0], v[1]); pv.y = pk2(v[2], v[3]); *(u32x2*)(dst + 16 * et) = pv; }
    __syncthreads();
}

constexpr int VST = 528;
constexpr int G1_LR = 0, G1_TOT = 8192, G1_KE = 10240, G1_V = G1_KE + 2 * 64 * 272, G1_B = G1_V + 64 * VST, G1_EB = G1_B + 2 * 64 * 128 * 4;
__device__ __forceinline__ void gla1_item(ArgsP a, int layer, int item, LAS unsigned char* lds) {
    const int tid = tid_op(), lane = tid & 63, w = __builtin_amdgcn_readfirstlane(tid >> 6), g = lane >> 4, i = lane & 15;
    const int n = item >> 2, h = item & 3, pos0 = 64 * n;
    const bf16_t* proj = (const bf16_t*)(a->ws + WS_PROJ);
    LAS float* lrs = (LAS float*)(lds + G1_LR);
    LAS float* tots = (LAS float*)(lds + G1_TOT);
    LAS unsigned char* KE = lds + G1_KE;
    LAS unsigned char* Vs = lds + G1_V;
    LAS float* Bs = (LAS float*)(lds + G1_B);
    LAS float* EB = (LAS float*)(lds + G1_EB);
    u32x4 q8[2], k8[2];
#pragma unroll
    for (int jj = 0; jj < 2; ++jj) { const int id = tid + 512 * jj, c = id >> 4, ch = id & 15; const bf16_t* rp = proj + (size_t)(pos0 + c) * NIN + h * 128 + 8 * ch;
        q8[jj] = *(const u32x4*)(rp + PQ); k8[jj] = *(const u32x4*)(rp + PK); }
    { const int c = tid >> 3, q4 = tid & 7;
      const u32x2 v = *(const u32x2*)(proj + (size_t)(pos0 + c) * NIN + LRF + 4 * q4);
      *(LAS f32x4*)(lrs + ((q4 >> 2) * 64 + c) * 16 + (q4 & 3) * 4) = (f32x4){bflo(v.x), bfhi(v.x), bflo(v.y), bfhi(v.y)}; }
#pragma unroll
    for (int jj = 0; jj < 4; ++jj) { const int id = tid + 512 * jj, c = id >> 5, ch = id & 31;
        *(LAS u32x4*)(Vs + c * VST + 16 * ch) = *(const u32x4*)(proj + (size_t)(pos0 + c) * NIN + PV + h * 256 + 8 * ch); }
    __syncthreads();
    {
        const int dir = tid >> 8, half = (tid >> 7) & 1, dk = tid & 127, col = h * 128 + dk;
        const float* up = a->in[dir ? I_UP_B : I_UP_F] + (size_t)layer * 16 * 512 + col;
        float upr[16];
#pragma unroll
        for (int r = 0; r < 16; ++r) upr[r] = up[r * 512];
        const float bias = a->in[dir ? I_BIAS_B : I_BIAS_F][layer * 512 + col];
        float gv[32];
#pragma unroll
        for (int jj = 0; jj < 32; ++jj) {
            const LAS f32x4* lp = (const LAS f32x4*)(lrs + (dir * 64 + half * 32 + jj) * 16);
            float lg = bias;
#pragma unroll
            for (int q = 0; q < 4; ++q) { const f32x4 lv = lp[q]; lg += lv[0] * upr[4 * q] + lv[1] * upr[4 * q + 1] + lv[2] * upr[4 * q + 2] + lv[3] * upr[4 * q + 3]; }
            const float l2 = __builtin_amdgcn_logf(1.0f + __builtin_amdgcn_exp2f(fabsf(lg) * -1.4426950408889634f));
            gv[jj] = fmaf(__builtin_amdgcn_fmed3f(lg, -3.0e38f, 0.f), 1.4426950408889634f / 16.0f, l2 * (-1.0f / 16.0f));
        }
        float tot;
        if (dir == 0) {
#pragma unroll
            for (int jj = 1; jj < 32; ++jj) gv[jj] += gv[jj - 1];
            tot = gv[31];
        } else {
#pragma unroll
            for (int jj = 30; jj >= 0; --jj) gv[jj] += gv[jj + 1];
            tot = gv[0];
        }
        tots[(dir * 2 + half) * 128 + dk] = tot;
        __syncthreads();
        const float t0 = tots[(dir * 2) * 128 + dk], t1 = tots[(dir * 2 + 1) * 128 + dk], blast = t0 + t1;
        const float add = dir == 0 ? (half == 1 ? t0 : 0.f) : (half == 0 ? t1 : 0.f);
#pragma unroll
        for (int jj = 0; jj < 32; ++jj) Bs[(dir * 64 + half * 32 + jj) * 128 + dk] = gv[jj] + add;
        if (half == 0) { const float eb = __builtin_amdgcn_exp2f(blast); EB[dir * 128 + dk] = eb; ((float*)(a->ws + WS_DEC))[((size_t)dir * 128 + n) * 512 + col] = eb; }
    }
    __syncthreads();
    {
        bf16_t* qd = (bf16_t*)(a->ws + WS_QD); bf16_t* ki = (bf16_t*)(a->ws + WS_KI);
#pragma unroll
        for (int jj = 0; jj < 2; ++jj) {
            const int id = tid + 512 * jj, c = id >> 4, ch = id & 15;
            float qv[8], kv[8];
#pragma unroll
            for (int e = 0; e < 4; ++e) { qv[2 * e] = bflo(q8[jj][e]); qv[2 * e + 1] = bfhi(q8[jj][e]); kv[2 * e] = bflo(k8[jj][e]); kv[2 * e + 1] = bfhi(k8[jj][e]); }
#pragma unroll
            for (int dr = 0; dr < 2; ++dr) {
                const LAS f32x4* bp = (const LAS f32x4*)(Bs + (dr * 64 + c) * 128 + 8 * ch);
                const LAS f32x4* ep = (const LAS f32x4*)(EB + dr * 128 + 8 * ch);
                const f32x4 b0 = bp[0], b1 = bp[1], e0 = ep[0], e1 = ep[1];
                float qo[8], ko[8], eo[8];
#pragma unroll
                for (int e = 0; e < 8; ++e) {
                    const float b = e < 4 ? b0[e & 3] : b1[e & 3], ebl = e < 4 ? e0[e & 3] : e1[e & 3];
                    qo[e] = qv[e] * __builtin_amdgcn_exp2f(b) * QSCALE; ko[e] = kv[e] * __builtin_amdgcn_exp2f(-b); eo[e] = ko[e] * ebl;
                }
                const size_t off = ((size_t)dr * SEQ + pos0 + c) * 512 + h * 128 + 8 * ch;
                u32x4 t; t.x = pk2(qo[0], qo[1]); t.y = pk2(qo[2], qo[3]); t.z = pk2(qo[4], qo[5]); t.w = pk2(qo[6], qo[7]); *(u32x4*)(qd + off) = t;
                t.x = pk2(ko[0], ko[1]); t.y = pk2(ko[2], ko[3]); t.z = pk2(ko[4], ko[5]); t.w = pk2(ko[6], ko[7]); *(u32x4*)(ki + off) = t;
                t.x = pk2(eo[0], eo[1]); t.y = pk2(eo[2], eo[3]); t.z = pk2(eo[4], eo[5]); t.w = pk2(eo[6], eo[7]); *(LAS u32x4*)(KE + (dr * 64 + c) * AST + 16 * ch) = t;
            }
        }
    }
    __syncthreads();
    bf16_t* ST = (bf16_t*)(a->ws + WS_ST);
#pragma unroll 1
    for (int dr = 0; dr < 2; ++dr) {
        f32x4 acc[8][2];
#pragma unroll
        for (int mt = 0; mt < 8; ++mt) { acc[mt][0] = (f32x4){0.f, 0.f, 0.f, 0.f}; acc[mt][1] = acc[mt][0]; }
#pragma unroll
        for (int kk = 0; kk < 2; ++kk) {
            bf16x8 bfr[2];
#pragma unroll
            for (int nt = 0; nt < 2; ++nt) { const LAS unsigned char* p0 = Vs + (32 * kk + 8 * g + (i >> 2)) * VST + (32 * w + 16 * nt + 4 * (i & 3)) * 2; bfr[nt] = tr8(p0, p0 + 4 * VST); }
#pragma unroll
            for (int mt = 0; mt < 8; ++mt) {
                const LAS unsigned char* p0 = KE + (dr * 64 + 32 * kk + 8 * g + (i >> 2)) * AST + (16 * mt + 4 * (i & 3)) * 2;
                const bf16x8 af = tr8(p0, p0 + 4 * AST);
                acc[mt][0] = mfma16(af, bfr[0], acc[mt][0]); acc[mt][1] = mfma16(af, bfr[1], acc[mt][1]);
            }
        }
        const int hd = h * 2 + dr;
#pragma unroll
        for (int nt = 0; nt < 2; ++nt) {
            bf16_t* drow = ST + (((size_t)hd * 128 + n) * 256 + 32 * w + 16 * nt + i) * 128 + 4 * g;
#pragma unroll
            for (int mt = 0; mt < 8; ++mt) { u32x2 pv; pv.x = pk2(acc[mt][nt][0], acc[mt][nt][1]); pv.y = pk2(acc[mt][nt][2], acc[mt][nt][3]); *(u32x2*)(drow + 16 * mt) = pv; }
        }
    }
    __syncthreads();
}

__device__ __forceinline__ void gla_scan(ArgsP a) {
    const int tid = tid_op();
    for (int wgi = bid_op(); wgi < 256; wgi += gridDim.x) {
        const int T = wgi * 512 + tid, dkp = T & 63, dv = (T >> 6) & 255, hd = T >> 14, dir = hd & 1, h = hd >> 1;
        const unsigned* st = (const unsigned*)(a->ws + WS_ST) + ((size_t)hd * 128 * 256 + dv) * 64 + dkp;
        unsigned* so = (unsigned*)(a->ws + WS_ST2) + ((size_t)hd * 128 * 256 + dv) * 64 + dkp;
        const f32x2* dec = (const f32x2*)(a->ws + WS_DEC) + (size_t)dir * 128 * 256 + h * 64 + dkp;
        float s0 = 0.f, s1 = 0.f;
#pragma unroll 1
        for (int nb = 0; nb < 128; nb += 8) {
            unsigned dsv[8]; f32x2 dcv[8];
#pragma unroll
            for (int u = 0; u < 8; ++u) { const int n = dir ? 127 - (nb + u) : nb + u; dsv[u] = st[(size_t)n * 16384]; dcv[u] = dec[(size_t)n * 256]; }
#pragma unroll
            for (int u = 0; u < 8; ++u) { const int n = dir ? 127 - (nb + u) : nb + u;
                so[(size_t)n * 16384] = pk2(s0, s1);
                s0 = dcv[u][0] * s0 + bflo(dsv[u]); s1 = dcv[u][1] * s1 + bfhi(dsv[u]); }
        }
    }
}

constexpr int G3_V = 0, G3_QD = 33792, G3_KI = G3_QD + 34816, G3_AT = G3_KI + 34816, G3_RED = G3_AT + 9216, ATS = 144;
__device__ __forceinline__ void gla3_item(ArgsP a, int layer, int item, LAS unsigned char* lds) {
    const int tid = tid_op(), lane = tid & 63, w = __builtin_amdgcn_readfirstlane(tid >> 6), g = lane >> 4, i = lane & 15;
    const int n = item >> 2, h = item & 3, pos0 = 64 * n;
    const bf16_t* proj = (const bf16_t*)(a->ws + WS_PROJ);
    const bf16_t* QD = (const bf16_t*)(a->ws + WS_QD); const bf16_t* KI = (const bf16_t*)(a->ws + WS_KI);
    LAS unsigned char* Vs = lds + G3_V; LAS unsigned char* Qs = lds + G3_QD; LAS unsigned char* Ksm = lds + G3_KI; LAS unsigned char* AT = lds + G3_AT;
    LAS float* red = (LAS float*)(lds + G3_RED);
    u32x4 sv[4], sq[4], sk[4];
#pragma unroll
    for (int jj = 0; jj < 4; ++jj) { const int id = tid + 512 * jj, c = id >> 5, ch = id & 31;
        sv[jj] = *(const u32x4*)(proj + (size_t)(pos0 + c) * NIN + PV + h * 256 + 8 * ch); }
#pragma unroll
    for (int jj = 0; jj < 4; ++jj) { const int id = tid + 512 * jj, dr = id >> 10, c = (id >> 4) & 63, ch = id & 15;
        const size_t off = ((size_t)dr * SEQ + pos0 + c) * 512 + h * 128 + 8 * ch;
        sq[jj] = *(const u32x4*)(QD + off); sk[jj] = *(const u32x4*)(KI + off); }
    const bf16_t* ST = (const bf16_t*)(a->ws + WS_ST2);
    bf16x8 sf[2][2][4];
#pragma unroll
    for (int dr = 0; dr < 2; ++dr)
#pragma unroll
        for (int et = 0; et < 2; ++et)
#pragma unroll
            for (int ks = 0; ks < 4; ++ks)
                sf[dr][et][ks] = *(const bf16x8*)(ST + ((((size_t)(h * 2 + dr)) * 128 + n) * 256 + 32 * w + 16 * et + i) * 128 + 32 * ks + 8 * g);
#pragma unroll
    for (int jj = 0; jj < 4; ++jj) { const int id = tid + 512 * jj, c = id >> 5, ch = id & 31; *(LAS u32x4*)(Vs + c * VST + 16 * ch) = sv[jj]; }
#pragma unroll
    for (int jj = 0; jj < 4; ++jj) { const int id = tid + 512 * jj, dr = id >> 10, c = (id >> 4) & 63, ch = id & 15;
        *(LAS u32x4*)(Qs + (dr * 64 + c) * AST + 16 * ch) = sq[jj]; *(LAS u32x4*)(Ksm + (dr * 64 + c) * AST + 16 * ch) = sk[jj]; }
    __syncthreads();
#pragma unroll
    for (int j = 0; j < 2; ++j) {
        const int pi = 2 * w + j, st = pi >> 2, ct = pi & 3;
        f32x4 at = (f32x4){0.f, 0.f, 0.f, 0.f};
        if (st <= ct) {
            f32x4 f = (f32x4){0.f, 0.f, 0.f, 0.f};
#pragma unroll
            for (int ks = 0; ks < 4; ++ks) f = mfma16(*(const LAS bf16x8*)(Ksm + (16 * st + i) * AST + (32 * ks + 8 * g) * 2), *(const LAS bf16x8*)(Qs + (16 * ct + i) * AST + (32 * ks + 8 * g) * 2), f);
#pragma unroll
            for (int r = 0; r < 4; ++r) at[r] += (16 * st + 4 * g + r <= 16 * ct + i) ? f[r] : 0.f;
        }
        if (st >= ct) {
            f32x4 f = (f32x4){0.f, 0.f, 0.f, 0.f};
#pragma unroll
            for (int ks = 0; ks < 4; ++ks) f = mfma16(*(const LAS bf16x8*)(Ksm + (64 + 16 * st + i) * AST + (32 * ks + 8 * g) * 2), *(const LAS bf16x8*)(Qs + (64 + 16 * ct + i) * AST + (32 * ks + 8 * g) * 2), f);
#pragma unroll
            for (int r = 0; r < 4; ++r) at[r] += (16 * st + 4 * g + r >= 16 * ct + i) ? f[r] : 0.f;
        }
        u32x2 pv; pv.x = pk2(at[0], at[1]); pv.y = pk2(at[2], at[3]);
        *(LAS u32x2*)(AT + (16 * ct + i) * ATS + (16 * st + 4 * g) * 2) = pv;
    }
    __syncthreads();
    f32x4 o[2][4];
#pragma unroll
    for (int et = 0; et < 2; ++et)
#pragma unroll
        for (int ct = 0; ct < 4; ++ct) o[et][ct] = (f32x4){0.f, 0.f, 0.f, 0.f};
#pragma unroll
    for (int kk = 0; kk < 2; ++kk) {
        bf16x8 vf[2];
#pragma unroll
        for (int et = 0; et < 2; ++et) { const LAS unsigned char* p0 = Vs + (32 * kk + 8 * g + (i >> 2)) * VST + (32 * w + 16 * et + 4 * (i & 3)) * 2; vf[et] = tr8(p0, p0 + 4 * VST); }
#pragma unroll
        for (int ct = 0; ct < 4; ++ct) {
            const bf16x8 bt = *(const LAS bf16x8*)(AT + (16 * ct + i) * ATS + (32 * kk + 8 * g) * 2);
            o[0][ct] = mfma16(vf[0], bt, o[0][ct]); o[1][ct] = mfma16(vf[1], bt, o[1][ct]);
        }
    }
#pragma unroll
    for (int dr = 0; dr < 2; ++dr)
#pragma unroll
        for (int ks = 0; ks < 4; ++ks)
#pragma unroll
            for (int ct = 0; ct < 4; ++ct) {
                const bf16x8 qf = *(const LAS bf16x8*)(Qs + (dr * 64 + 16 * ct + i) * AST + (32 * ks + 8 * g) * 2);
                o[0][ct] = mfma16(sf[dr][0][ks], qf, o[0][ct]); o[1][ct] = mfma16(sf[dr][1][ks], qf, o[1][ct]);
            }
#pragma unroll
    for (int ct = 0; ct < 4; ++ct) {
        float ss = 0.f;
#pragma unroll
        for (int et = 0; et < 2; ++et) ss += (o[et][ct][0] * o[et][ct][0] + o[et][ct][1] * o[et][ct][1]) + (o[et][ct][2] * o[et][ct][2] + o[et][ct][3] * o[et][ct][3]);
        ss += __shfl_xor(ss, 16); ss += __shfl_xor(ss, 32);
        if (g == 0) red[w * 64 + 16 * ct + i] = ss;
    }
    __syncthreads();
    const float* gn = a->in[I_GLA_NORM] + layer * 1024 + h * 256 + 32 * w + 4 * g;
    const f32x4 gv0 = *(const f32x4*)gn, gv1 = *(const f32x4*)(gn + 16);
#pragma unroll
    for (int ct = 0; ct < 4; ++ct) {
        float tot = 0.f;
#pragma unroll
        for (int ww = 0; ww < 8; ++ww) tot += red[ww * 64 + 16 * ct + i];
        const float rs = __builtin_amdgcn_rsqf(tot * (1.0f / 256.0f) + EPS);
        const size_t pos = pos0 + 16 * ct + i;
        const int colb = h * 256 + 32 * w + 4 * g;
        const bf16_t* rp = proj + pos * NIN + PR + colb;
        bf16_t* dst = (bf16_t*)(a->ws + WS_MIX) + pos * DM + colb;
#pragma unroll
        for (int et = 0; et < 2; ++et) {
            const u32x2 rv = *(const u32x2*)(rp + 16 * et);
            const float r0 = bflo(rv.x), r1 = bfhi(rv.x), r2 = bflo(rv.y), r3 = bfhi(rv.y);
            f32x4 v = o[et][ct] * rs * (et ? gv1 : gv0);
            v[0] *= r0 * __builtin_amdgcn_rcpf(1.0f + fexp(-r0)); v[1] *= r1 * __builtin_amdgcn_rcpf(1.0f + fexp(-r1)); v[2] *= r2 * __builtin_amdgcn_rcpf(1.0f + fexp(-r2)); v[3] *= r3 * __builtin_amdgcn_rcpf(1.0f + fexp(-r3));
            u32x2 pv; pv.x = pk2(v[0], v[1]); pv.y = pk2(v[2], v[3]); *(u32x2*)(dst + 16 * et) = pv;
        }
    }
    __syncthreads();
}

__device__ __forceinline__ void dil_combine(ArgsP a, int layer) {
    const int tid = tid_op(), lane = tid & 63, w = __builtin_amdgcn_readfirstlane(tid >> 6), g = lane >> 4, i = lane & 15;
    const int gw = bid_op() * 8 + w, NGW = gridDim.x * 8;
    const bf16_t* DO = (const bf16_t*)(a->ws + WS_DILO); const float* DL = (const float*)(a->ws + WS_DILL);
    for (int wi = gw; wi < SEQ; wi += NGW) {
        const int pair = wi * 4 + g, token = pair >> 2, h = pair & 3;
        const float l0 = DL[((size_t)0 * SEQ + token) * 4 + h], l1 = DL[((size_t)1 * SEQ + token) * 4 + h], l2 = DL[((size_t)2 * SEQ + token) * 4 + h];
        const float mx = fmaxf(l0, fmaxf(l1, l2));
        float w0 = fexp(l0 - mx), w1 = fexp(l1 - mx), w2 = fexp(l2 - mx);
        const float inv = 1.0f / (w0 + w1 + w2); w0 *= inv; w1 *= inv; w2 *= inv;
        const size_t eo = (size_t)token * 512 + h * 128 + 8 * i;
        const u32x4 a0 = *(const u32x4*)(DO + eo), a1 = *(const u32x4*)(DO + (size_t)SEQ * 512 + eo), a2 = *(const u32x4*)(DO + (size_t)2 * SEQ * 512 + eo);
        float v[8];
#pragma unroll
        for (int q = 0; q < 4; ++q) { v[2 * q] = w0 * bflo(a0[q]) + w1 * bflo(a1[q]) + w2 * bflo(a2[q]); v[2 * q + 1] = w0 * bfhi(a0[q]) + w1 * bfhi(a1[q]) + w2 * bfhi(a2[q]); }
        float ss = 0.f;
#pragma unroll
        for (int q = 0; q < 8; ++q) ss += v[q] * v[q];
        ss += __shfl_xor(ss, 1); ss += __shfl_xor(ss, 2); ss += __shfl_xor(ss, 4); ss += __shfl_xor(ss, 8);
        const float rs = __builtin_amdgcn_rsqf(ss * (1.0f / 128.0f) + EPS);
        const float* gn = a->in[I_DIL_NORM] + layer * 512 + h * 128 + 8 * i;
        const f32x4 g0 = *(const f32x4*)gn, g1 = *(const f32x4*)(gn + 4);
        u32x4 ov; ov.x = pk2(v[0] * rs * g0[0], v[1] * rs * g0[1]); ov.y = pk2(v[2] * rs * g0[2], v[3] * rs * g0[3]); ov.z = pk2(v[4] * rs * g1[0], v[5] * rs * g1[1]); ov.w = pk2(v[6] * rs * g1[2], v[7] * rs * g1[3]);
        *(u32x4*)((bf16_t*)(a->ws + WS_MIX) + (size_t)token * DM + 1024 + h * 128 + 8 * i) = ov;
    }
}

__device__ __forceinline__ void phase_final(ArgsP a) {
    const int tid = tid_op(), lane = tid & 63, w = __builtin_amdgcn_readfirstlane(tid >> 6);
    const int gw = bid_op() * 8 + w, NGW = gridDim.x * 8;
    const float* X = (const float*)(a->ws + WS_X); const float* gn = a->in[I_NORM_FINAL];
    for (int r = gw; r < SEQ; r += NGW) {
        f32x4 v[8]; float s = 0.f;
#pragma unroll
        for (int jj = 0; jj < 8; ++jj) { v[jj] = *((const f32x4*)(X + (size_t)r * DM) + 64 * jj + lane); s += (v[jj][0] * v[jj][0] + v[jj][1] * v[jj][1]) + (v[jj][2] * v[jj][2] + v[jj][3] * v[jj][3]); }
        s = wave_sum(s);
        const float rs = 1.0f / sqrtf(s * (1.0f / 2048.0f) + EPS);
#pragma unroll
        for (int jj = 0; jj < 8; ++jj) { const f32x4 gv = *((const f32x4*)gn + 64 * jj + lane); *((f32x4*)(a->out + (size_t)r * DM) + 64 * jj + lane) = v[jj] * rs * gv; }
    }
}


#ifndef DBG_BUF
#define DBG_BUF 0
#endif
__device__ __forceinline__ void phase_dbg(ArgsP a) {
    const int tid = tid_op();
    const bf16_t* proj = (const bf16_t*)(a->ws + WS_PROJ); const bf16_t* mkv = (const bf16_t*)(a->ws + WS_MEMKV); const bf16_t* mix = (const bf16_t*)(a->ws + WS_MIX);
    for (size_t e = (size_t)bid_op() * 512 + tid; e < (size_t)SEQ * DM; e += (size_t)gridDim.x * 512) {
        const size_t r = e / DM, c = e % DM; float v = 0.f;
        if (DBG_BUF == 1) { v = bf2f(proj[r * NIN + c]) + bf2f(proj[r * NIN + c + 2048]) + (c < 1056 ? bf2f(proj[r * NIN + c + 4096]) : 0.f); if (r < 256) v += bf2f(mkv[r * 4096 + c]) + bf2f(mkv[r * 4096 + c + 2048]); }
        if (DBG_BUF == 2) v = bf2f(mix[r * DM + c]);
        if (DBG_BUF == 3) { const bf16_t* qd = (const bf16_t*)(a->ws + WS_QD); const bf16_t* ki = (const bf16_t*)(a->ws + WS_KI); const bf16_t* dl = (const bf16_t*)(a->ws + WS_DILO);
            v = bf2f(qd[r * 512 + (c & 511)]) + bf2f(qd[(SEQ + r) * 512 + (c & 511)]) + bf2f(ki[r * 512 + (c & 511)]) + bf2f(ki[(SEQ + r) * 512 + (c & 511)]) + bf2f(dl[((c >> 9) % 3 * SEQ + r) * 512 + (c & 511)]); }
        if (DBG_BUF == 5) { const bf16_t* qd = (const bf16_t*)(a->ws + WS_QD); const bf16_t* ki = (const bf16_t*)(a->ws + WS_KI); v = bf2f(qd[r * 512 + (c & 511)]) + bf2f(qd[(SEQ + r) * 512 + (c & 511)]) + bf2f(ki[r * 512 + (c & 511)]) + bf2f(ki[(SEQ + r) * 512 + (c & 511)]); }
        if (DBG_BUF == 7) { v = ((const float*)(a->ws + WS_DILL))[e % (3 * SEQ * 4)]; }
        if (DBG_BUF == 4) { const bf16_t* st = (const bf16_t*)(a->ws + WS_ST); v = 0.f; for (int j = 0; j < 16; ++j) v += bf2f(st[e * 16 + j]); }
        a->out[e] = v;
    }
}

#ifndef PROBE_EXTRA_SYNC
#define PROBE_EXTRA_SYNC 0
#endif
#ifndef PROBE_ITEM
#define PROBE_ITEM 0
#endif
#ifndef PROBE_REP_PH
#define PROBE_REP_PH -1
#endif
#ifndef PROBE_REP_SUB
#define PROBE_REP_SUB -1
#endif
__device__ __forceinline__ void run_phase(ArgsP a, int ph, LAS unsigned char* lds, int G) {
        if (ph == 0) { phase_prep(a, lds); return; }
        if (ph == NPHASE - 1) { if (DBG_BUF) phase_dbg(a); else phase_final(a); return; }
        const int layer = (ph - 1) / 7, sub = (ph - 1) % 7;
        if (sub == 0 || sub == 5) {
            pg8::Gemm g; pg8::EpiProj E;
            if (sub == 0) { g = pg8::Gemm{(const bf16_t*)(a->ws + WS_XB2), layer == 0 ? (const bf16_t*)(a->ws + WS_WIN0) : (const bf16_t*)(a->ws + WS_WIN) + (size_t)layer * NIN * DM, SEQ, NIN, DM};
                E = pg8::EpiProj{(bf16_t*)(a->ws + WS_PROJ), NIN, (const float*)(a->ws + WS_SSQ), 0, (bf16_t*)(a->ws + WS_MEMKV), 4096, (const float*)(a->ws + WS_SSQM), 32, 21, (LAS float*)(lds + pg8::STAGE_BYTES)}; }
            else { g = pg8::Gemm{(const bf16_t*)(a->ws + WS_XB2), (const bf16_t*)(a->ws + WS_WUP) + (size_t)layer * DFF * DM, SEQ, DFF, DM};
                E = pg8::EpiProj{(bf16_t*)(a->ws + WS_U), DFF, (const float*)(a->ws + WS_SSQ), 1, nullptr, 0, nullptr, 1 << 20, 0, (LAS float*)(lds + pg8::STAGE_BYTES)}; }
            pg8::StaticOrder S; S.init(g.M, g.N, G, bid_op());
            if (sub == 0 && layer == 0) { S.n_extra = 16; S.ex_pm = 32; S.ex_pn0 = 21; }
            E.fill_row_scales(S);
            pg8::gemm_phase<pg8::EpiProj>(lds, g, S, E);
        } else if (sub == 4 || sub == 6) {
            pg8::Gemm g;
            if (sub == 4) g = pg8::Gemm{(const bf16_t*)(a->ws + WS_MIX), (const bf16_t*)(a->ws + WS_WOUT) + (size_t)layer * DM * DM, SEQ, DM, DM};
            else g = pg8::Gemm{(const bf16_t*)(a->ws + WS_U), (const bf16_t*)(a->ws + WS_WDN) + (size_t)layer * DM * DFF, SEQ, DM, DFF};
            pg8::EpiResid E{(layer == 0 && sub == 4) ? a->in[I_X] : (const float*)(a->ws + WS_X), (float*)(a->ws + WS_X), (bf16_t*)(a->ws + WS_XB2), (float*)(a->ws + WS_SSQ)};
            pg8::StaticOrder S; S.init(g.M, g.N, G, bid_op());
            pg8::gemm_phase<pg8::EpiResid>(lds, g, S, E);
        } else if (sub == 1) {
            int it = bid_op();
            for (; it < 512; it += G) gla1_item(a, layer, it, lds);
            it = 512 + dil_items(a, it - 512, G, lds);
            for (; it < 1536; it += G) mem_item(a, layer, it - 1280, lds);
        } else if (sub == 2) {
            gla_scan(a);
        } else if (sub == 3) {
            for (int it = bid_op(); it < 512; it += G) { gla3_item(a, layer, it, lds); if (PROBE_ITEM == 4) gla3_item(a, layer, it, lds); }
            dil_combine(a, layer); if (PROBE_ITEM == 5) dil_combine(a, layer);
        }
}

__global__ void __launch_bounds__(512, 2) hymba_fwd(Args a_) {
    extern __shared__ __attribute__((aligned(16))) unsigned char lds_raw[];
    LAS unsigned char* lds = (LAS unsigned char*)lds_raw;
    cg::grid_group grid = cg::this_grid();
    const int G = gridDim.x;
    const int ph_lo = a_.ph_lo, ph_hi = a_.ph_hi;
    if (ph_lo < 0) grid.sync();
    volatile LAS unsigned* misc = (volatile LAS unsigned*)(lds + LDS_MISC);
    if (threadIdx.x < 2) misc[threadIdx.x] = 0u;
    __syncthreads();
    XcdBarrier bar; bar.bar = (unsigned*)(a_.ws + WS_BAR); bar.x = 0; bar.st = nullptr;
    if (ph_hi - ph_lo > 1) bar = xcd_barrier_post((unsigned*)(a_.ws + WS_BAR), misc);
    for (int ph = ph_lo; ph < ph_hi; ++ph) {
        const int nrep = ((PROBE_REP_PH >= 0 && ph == PROBE_REP_PH) || (PROBE_REP_SUB >= 0 && ph >= 1 && ph < NPHASE - 1 && (ph - 1) % 7 == PROBE_REP_SUB)) ? 2 : 1;
        for (int rep = 0; rep < nrep; ++rep) {
            if (ph > ph_lo || rep) { xcd_barrier(bar); for (int xs = 0; xs < PROBE_EXTRA_SYNC; ++xs) xcd_barrier(bar); }
            ArgsP a = (ArgsP)__builtin_amdgcn_kernarg_segment_ptr(); asm volatile("" : "+s"(a));
            run_phase(a, ph, lds, G);
        }
    }
}

extern "C" void kernel_launch(void* const* d_in, const int* in_sizes, int n_in, void* d_out, int out_size, void* d_ws, size_t ws_size, hipStream_t stream) {
    static int grid = 0;
    if (grid == 0) {
        if (n_in != 19 || ws_size < WS_END) { fprintf(stderr, "kernel_launch: unexpected n_in %d / ws_size %zu\n", n_in, ws_size); grid = -1; return; }
        int dev = 0, cus = 0, per_cu = 0;
        (void)hipGetDevice(&dev); (void)hipDeviceGetAttribute(&cus, hipDeviceAttributeMultiprocessorCount, dev);
        if (hipFuncSetAttribute((const void*)hymba_fwd, hipFuncAttributeMaxDynamicSharedMemorySize, LDS_BYTES) != hipSuccess) { fprintf(stderr, "kernel_launch: hipFuncSetAttribute failed\n"); grid = -1; return; }
        if (hipOccupancyMaxActiveBlocksPerMultiprocessor(&per_cu, (const void*)hymba_fwd, 512, LDS_BYTES) != hipSuccess || per_cu < 1) { fprintf(stderr, "kernel_launch: occupancy query gave %d\n", per_cu); per_cu = 1; }
        (void)hipGetLastError();
        grid = cus * per_cu;
    }
    if (grid < 0) return;
    Args a{};
    for (int i = 0; i < 19; ++i) a.in[i] = (const float*)d_in[i];
    a.out = (float*)d_out; a.ws = (unsigned char*)d_ws;
#if MK_MULTI
    for (int ph = 0; ph < NPHASE; ++ph) { if (ph > DBG_LAST && ph != NPHASE - 1) continue; a.ph_lo = ph; a.ph_hi = ph + 1; hipLaunchKernelGGL(hymba_fwd, dim3(grid), dim3(512), LDS_BYTES, stream, a); }
#else
    a.ph_lo = 0; a.ph_hi = NPHASE;
    (void)hipMemsetAsync((unsigned char*)d_ws + WS_BAR, 0, 16384, stream);
    void* args[] = {&a};
    hipError_t e = hipLaunchCooperativeKernel((const void*)hymba_fwd, dim3(grid), dim3(512), args, LDS_BYTES, stream);
    if (e != hipSuccess) fprintf(stderr, "cooperative launch failed: %s (grid %d)\n", hipGetErrorString(e), grid);
#endif
}
```

```cpp
#include <hip/hip_runtime.h>
#include <hip/hip_cooperative_groups.h>
#include <cstdio>
#include <cstdint>
namespace cg = cooperative_groups;

#ifndef MK_MULTI
#define MK_MULTI 0
#endif

#ifndef DBG_LAST
#define DBG_LAST 1000
#endif
#define LAS __attribute__((address_space(3)))
typedef unsigned short bf16_t;
typedef short bf16x8 __attribute__((ext_vector_type(8)));
typedef short s16x4 __attribute__((ext_vector_type(4)));
typedef short v4i16_t __attribute__((ext_vector_type(4)));
typedef float f32x4 __attribute__((ext_vector_type(4)));
typedef float f32x2 __attribute__((ext_vector_type(2)));
typedef unsigned u32x4 __attribute__((ext_vector_type(4)));
typedef unsigned u32x2 __attribute__((ext_vector_type(2)));

constexpr int SEQ = 8192, DM = 2048, DEPTH = 4, DFF = 8192, MEML = 256;
constexpr int NIN = 5376;
constexpr int NIN_SRC = 5152;
constexpr int PQ = 0, PK = 512, PV = 1024, PR = 2048, DQ = 3072, DKo = 3584, DVo = 4096, MQ = 4608, LRF = 5120;
constexpr float EPS = 1e-6f;
constexpr float QSCALE = 0.08838834764831845f;

constexpr size_t MiB = 1u << 20;
constexpr size_t WS_WIN = 0;
constexpr size_t WS_WOUT = 84 * MiB;
constexpr size_t WS_WUP = 116 * MiB;
constexpr size_t WS_WDN = 244 * MiB;
constexpr size_t WS_WMKV = 372 * MiB;
constexpr size_t WS_X = 388 * MiB;
constexpr size_t WS_XB = 452 * MiB;
constexpr size_t WS_PROJ = 484 * MiB;
constexpr size_t WS_MIX = 568 * MiB;
constexpr size_t WS_U = 600 * MiB;
constexpr size_t WS_ST = WS_U;
constexpr size_t WS_QD = WS_U + 64 * MiB;
constexpr size_t WS_KI = WS_U + 80 * MiB;
constexpr size_t WS_DILO = WS_U + 96 * MiB;
constexpr size_t WS_DILL = WS_U + 120 * MiB;
constexpr size_t WS_MEMB = 728 * MiB;
constexpr size_t WS_MEMKV = 729 * MiB;
constexpr size_t WS_SSQ = 731 * MiB;
constexpr size_t WS_DEC = 732 * MiB;
constexpr size_t WS_SSQM = 733 * MiB;
constexpr size_t WS_ST2 = 734 * MiB;
constexpr size_t WS_BAR = 798 * MiB;
constexpr size_t WS_XB2 = 800 * MiB;
constexpr size_t WS_MEMB2 = 832 * MiB;
constexpr size_t WS_WIN0 = 834 * MiB;
constexpr size_t WS_WMKV2 = 855 * MiB;
constexpr size_t WS_END = 871 * MiB;

constexpr int LDS_BYTES = 148992;
constexpr int LDS_MISC = 148736;

typedef __bf16 bf16x2_t __attribute__((ext_vector_type(2)));
__device__ __forceinline__ unsigned pk2(float lo, float hi) { bf16x2_t v = {(__bf16)lo, (__bf16)hi}; return __builtin_bit_cast(unsigned, v); }
__device__ __forceinline__ unsigned cvt_pk_bf16(float lo, float hi) { return pk2(lo, hi); }
__device__ __forceinline__ bf16_t f2bf(float f) { return (bf16_t)(pk2(f, 0.f) & 0xffffu); }
__device__ __forceinline__ float bf2f(bf16_t b) { return __uint_as_float(((unsigned)b) << 16); }
__device__ __forceinline__ float bflo(unsigned w) { return __uint_as_float(w << 16); }
__device__ __forceinline__ float bfhi(unsigned w) { return __uint_as_float(w & 0xffff0000u); }
__device__ __forceinline__ s16x4 tr4(const LAS unsigned char* p) { return __builtin_bit_cast(s16x4, __builtin_amdgcn_ds_read_tr16_b64_v4i16((LAS v4i16_t*)p)); }
__device__ __forceinline__ bf16x8 tr8(const LAS unsigned char* p0, const LAS unsigned char* p1) {
    const s16x4 a = tr4(p0), b = tr4(p1);
    return (bf16x8){a[0], a[1], a[2], a[3], b[0], b[1], b[2], b[3]};
}
__device__ __forceinline__ float fexp(float x) { return __builtin_amdgcn_exp2f(x * 1.4426950408889634f); }
__device__ __forceinline__ float flog(float x) { return __builtin_amdgcn_logf(x) * 0.6931471805599453f; }
__device__ __forceinline__ f32x4 mfma16(bf16x8 a, bf16x8 b, f32x4 c) { return __builtin_amdgcn_mfma_f32_16x16x32_bf16(a, b, c, 0, 0, 0); }
__device__ __forceinline__ float wave_sum(float v) {
#pragma unroll
    for (int o = 1; o < 64; o <<= 1) v += __shfl_xor(v, o);
    return v;
}


__device__ __forceinline__ int tid_op() { int t = threadIdx.x; asm volatile("" : "+v"(t)); return t; }
__device__ __forceinline__ int bid_op() { int b = blockIdx.x; asm volatile("" : "+s"(b)); return b; }

namespace pg8 {
#define PG8_LAS __attribute__((address_space(3)))
constexpr int BM = 256, BK = 64, HALF = 128, HTB = HALF * BK * 2, STAGE_BYTES = 8 * HTB, NXCD = 8, WGM = 8;
__host__ __device__ __forceinline__ int lds_byte(int r, int c) { const int st = (r >> 4) * 2 + (c >> 5), rr = r & 15, cc = c & 31, ob = rr * 64 + cc * 2; return st * 1024 + (ob ^ (((ob >> 9) & 1) << 5)); }
__host__ __device__ __forceinline__ void stage_rc(int b, int& R, int& C) { const int st = b / 1024, sb = b % 1024, swz = sb ^ (((sb >> 9) & 1) << 5); R = (st >> 1) * 16 + swz / 64; C = (st & 1) * 32 + (swz % 64) / 2; }
__host__ __device__ __forceinline__ int perm32(int rho) { const int n = rho >> 4, i = rho & 15; return 8 * (i >> 2) + 4 * n + (i & 3); }
struct Unit { int pm, pn, idx; };
struct Gemm { const bf16_t* A; const bf16_t* Bt; int M, N, K; };
struct StaticOrder {
    int nM, nN, nwg, G, c, n_extra, ex_pm, ex_pn0;
    __device__ __forceinline__ void init(int M, int N, int G_, int c_) { nM = M / BM; nN = N / BM; nwg = nM * nN; G = G_; c = c_; n_extra = 0; ex_pm = 0; ex_pn0 = 0; }
    __device__ __forceinline__ bool next(int i, Unit& u) const {
        const long L = (long)i * G + c; if (L >= nwg + n_extra) return false;
        u.idx = i;
        if (L >= nwg) { u.pm = ex_pm; u.pn = ex_pn0 + (int)(L - nwg); return true; }
        int wgid = (int)L; { const int q = nwg / NXCD, r = nwg % NXCD, xcd = wgid % NXCD, off = wgid / NXCD; wgid = (xcd < r ? xcd * (q + 1) : r * (q + 1) + (xcd - r) * q) + off; }
        const int nig = WGM * nN, gid = wgid / nig, fm = gid * WGM, gsz = (nM - fm) < WGM ? (nM - fm) : WGM;
        u.pm = fm + ((wgid % nig) % gsz); u.pn = (wgid % nig) / gsz; return true;
    }
};

struct EpiProj {
    static constexpr bool PERM = true;
    bf16_t* O; int ldc; const float* ssq; int act;
    bf16_t* O2; int ldc2; const float* ssq2; int alt_pm, alt_pn0; PG8_LAS float* rsq;
    __device__ __forceinline__ void operator()(const f32x4 (&acc)[2][2][4][2], const Unit& u, int wr, int wc, int fr, int fq) const {
        const bool alt = u.pm >= alt_pm;
        bf16_t* const O = alt ? O2 : this->O; const int ldc = alt ? ldc2 : this->ldc;
        const int row0 = (alt ? u.pm - alt_pm : u.pm) * BM + wr * 64 + fr, col0 = (alt ? u.pn - alt_pn0 : u.pn) * BM + wc * 32 + 8 * fq;
        const PG8_LAS float* rst = rsq + u.idx * BM + wr * 64 + fr;
#pragma unroll
        for (int ai = 0; ai < 2; ++ai)
#pragma unroll
            for (int m = 0; m < 4; ++m) {
                const int row = row0 + ai * HALF + m * 16;
                const float rs = rst[ai * HALF + m * 16];
                bf16_t* rowp = O + (size_t)row * ldc + col0;
#pragma unroll
                for (int bj = 0; bj < 2; ++bj) {
                    f32x4 v0 = acc[ai][bj][m][0] * rs, v1 = acc[ai][bj][m][1] * rs;
                    if (act) {
                        f32x4 r0, r1;
#pragma unroll
                        for (int j = 0; j < 4; ++j) { r0[j] = __builtin_amdgcn_fmed3f(v0[j], 0.f, 3.0e38f); r1[j] = __builtin_amdgcn_fmed3f(v1[j], 0.f, 3.0e38f); }
                        v0 = r0 * r0; v1 = r1 * r1;
                    }
                    u32x4 w; w.x = cvt_pk_bf16(v0[0], v0[1]); w.y = cvt_pk_bf16(v0[2], v0[3]); w.z = cvt_pk_bf16(v1[0], v1[1]); w.w = cvt_pk_bf16(v1[2], v1[3]);
                    *(u32x4*)(rowp + bj * HALF) = w;
                }
            }
    }
    __device__ __forceinline__ void fill_row_scales(const StaticOrder& S) const {
        const int tid = tid_op(), r = tid >> 1, hf = tid & 1;
        Unit u;
#pragma unroll 1
        for (int i = 0; S.next(i, u); ++i) {
            const bool alt = u.pm >= alt_pm;
            const float* sp = (alt ? ssq2 : ssq) + ((size_t)(alt ? u.pm - alt_pm : u.pm) * BM + r) * 32 + hf * 16;
            const f32x4 a0 = *(const f32x4*)sp, a1 = *(const f32x4*)(sp + 4), a2 = *(const f32x4*)(sp + 8), a3 = *(const f32x4*)(sp + 12);
            float s = (((a0[0] + a0[1]) + (a0[2] + a0[3])) + ((a1[0] + a1[1]) + (a1[2] + a1[3]))) + (((a2[0] + a2[1]) + (a2[2] + a2[3])) + ((a3[0] + a3[1]) + (a3[2] + a3[3])));
            s += __shfl_xor(s, 1);
            if (hf == 0) rsq[i * BM + r] = __builtin_amdgcn_rsqf(s * (1.0f / 2048.0f) + EPS);
        }
        __syncthreads();
    }
};
struct EpiResid {
    static constexpr bool PERM = false;
    const float* Xin; float* X; bf16_t* XB; float* ssq; int nobf = 0;
    __device__ __forceinline__ void operator()(const f32x4 (&acc)[2][2][4][2], const Unit& u, int wr, int wc, int fr, int fq) const {
        const int row0 = u.pm * BM + wr * 64 + fr, col0 = u.pn * BM + wc * 32 + 4 * fq;
        f32x4 xc[2][2], xn[2][2];
#pragma unroll
        for (int bj = 0; bj < 2; ++bj)
#pragma unroll
            for (int n = 0; n < 2; ++n) xc[bj][n] = *(const f32x4*)(Xin + (size_t)row0 * DM + col0 + bj * HALF + n * 16);
#pragma unroll
        for (int k = 0; k < 8; ++k) {
            const int ai = k >> 2, m = k & 3;
            const int row = row0 + ai * HALF + m * 16;
            const size_t off = (size_t)row * DM + col0;
            if (k < 7) {
                const size_t offn = (size_t)(row0 + ((k + 1) >> 2) * HALF + ((k + 1) & 3) * 16) * DM + col0;
#pragma unroll
                for (int bj = 0; bj < 2; ++bj)
#pragma unroll
                    for (int n = 0; n < 2; ++n) xn[bj][n] = *(const f32x4*)(Xin + offn + bj * HALF + n * 16);
            }
            float sq = 0.f;
#pragma unroll
            for (int bj = 0; bj < 2; ++bj)
#pragma unroll
                for (int n = 0; n < 2; ++n) {
                    const size_t o = off + bj * HALF + n * 16;
                    const f32x4 xv = xc[bj][n] + acc[ai][bj][m][n];
                    *(f32x4*)(X + o) = xv;
                    u32x2 w; w.x = cvt_pk_bf16(xv[0], xv[1]); w.y = cvt_pk_bf16(xv[2], xv[3]);
                    if (!nobf) *(u32x2*)(XB + o) = w;
                    sq += (xv[0] * xv[0] + xv[1] * xv[1]) + (xv[2] * xv[2] + xv[3] * xv[3]);
                }
            sq += __shfl_xor(sq, 16); sq += __shfl_xor(sq, 32);
            if (fq == 0 && !nobf) ssq[(size_t)row * 32 + u.pn * 4 + wc] = sq;
#pragma unroll
            for (int bj = 0; bj < 2; ++bj)
#pragma unroll
                for (int n = 0; n < 2; ++n) xc[bj][n] = xn[bj][n];
        }
    }
};

template <class Epi>
__device__ __forceinline__ void gemm_phase(PG8_LAS unsigned char* lds, const Gemm g, const StaticOrder& S, const Epi& E) {
    const int tid = tid_op(), wid = __builtin_amdgcn_readfirstlane(tid >> 6), lane = tid & 63, wr = wid >> 2, wc = wid & 3, fr = lane & 15, fq = lane >> 4;
    const int K = g.K, nt = K / BK;
    unsigned voffA[2], voffB[2];
#pragma unroll
    for (int i = 0; i < 2; ++i) { int R, C; stage_rc(tid * 16 + i * 8192, R, C); const int Rb = Epi::PERM ? ((R & ~31) + perm32(R & 31)) : R;
        voffA[i] = (unsigned)(R * K + C) * 2u; voffB[i] = (unsigned)(Rb * K + C) * 2u; }
    const size_t kstep = (size_t)(BK * 2);
    const size_t hstep = (size_t)HALF * K * 2;
    const size_t tstep = 2 * hstep;
    const unsigned ldsw = (unsigned)wid * 1024u;
    const int aoff = lds_byte(wr * 64 + fr, fq * 8), boff = lds_byte(wc * 32 + fr, fq * 8);
#define PG8_SA(b, h) (((b) * 2 + (h)) * HTB)
#define PG8_SB(b, h) ((4 + (b) * 2 + (h)) * HTB)
#define PG8_STAGE(bufoff, gbase, voff) do { _Pragma("unroll") for (int _i = 0; _i < 2; ++_i) \
        __builtin_amdgcn_global_load_lds((const unsigned*)((const char*)(gbase) + (voff)[_i]), (PG8_LAS unsigned*)(lds + (bufoff) + ldsw + _i * 8192), 16, 0, 0); } while (0)
#define PG8_LDA(dst, b, h) do { _Pragma("unroll") for (int m = 0; m < 4; ++m) _Pragma("unroll") for (int k = 0; k < 2; ++k) dst[m][k] = *(const PG8_LAS bf16x8*)(lds + PG8_SA(b, h) + aoff + m * 2048 + k * 1024); } while (0)
#define PG8_LDB(dst, b, h) do { _Pragma("unroll") for (int n = 0; n < 2; ++n) _Pragma("unroll") for (int k = 0; k < 2; ++k) dst[n][k] = *(const PG8_LAS bf16x8*)(lds + PG8_SB(b, h) + boff + n * 2048 + k * 1024); } while (0)
#define PG8_MMA(ai, bj, At, Bt) do { __builtin_amdgcn_s_setprio(1); _Pragma("unroll") for (int m = 0; m < 4; ++m) _Pragma("unroll") for (int n = 0; n < 2; ++n) _Pragma("unroll") for (int k = 0; k < 2; ++k) \
        acc[ai][bj][m][n] = __builtin_amdgcn_mfma_f32_16x16x32_bf16(Bt[n][k], At[m][k], acc[ai][bj][m][n], 0, 0, 0); __builtin_amdgcn_s_setprio(0); } while (0)
#define PG8_WAIT_V(n) asm volatile("s_waitcnt vmcnt(" #n ")" ::: "memory")
#define PG8_WAIT_L(n) asm volatile("s_waitcnt lgkmcnt(" #n ")" ::: "memory")
#define PG8_BAR __builtin_amdgcn_s_barrier()
#define PG8_SCHED __builtin_amdgcn_sched_barrier(0)
    Unit cur, nxt; int ui = 0;
    if (!S.next(0, cur)) return;
    f32x4 acc[2][2][4][2];
#pragma unroll
    for (int a = 0; a < 2; ++a)
#pragma unroll
        for (int b = 0; b < 2; ++b)
#pragma unroll
            for (int m = 0; m < 4; ++m)
#pragma unroll
                for (int n = 0; n < 2; ++n) acc[a][b][m][n] = (f32x4){0.f, 0.f, 0.f, 0.f};
    bf16x8 At[4][2], B0[2][2], B1[2][2];
    const char* cA = (const char*)g.A + (size_t)cur.pm * tstep; const char* cB = (const char*)g.Bt + (size_t)cur.pn * tstep;
    PG8_STAGE(PG8_SB(0, 0), cB, voffB); PG8_STAGE(PG8_SB(0, 1), cB + hstep, voffB); PG8_STAGE(PG8_SA(0, 0), cA, voffA); PG8_STAGE(PG8_SA(0, 1), cA + hstep, voffA);
    if (wr == 1) PG8_BAR;
    PG8_WAIT_V(2); PG8_BAR;
    PG8_STAGE(PG8_SB(1, 0), cB + kstep, voffB); PG8_STAGE(PG8_SA(1, 0), cA + kstep, voffA); PG8_STAGE(PG8_SB(1, 1), cB + hstep + kstep, voffB);
    PG8_WAIT_V(6); PG8_BAR;
    for (;;) {
        const bool has_next = S.next(ui + 1, nxt);
        const char* nA = has_next ? (const char*)g.A + (size_t)nxt.pm * tstep : cA; const char* nB = has_next ? (const char*)g.Bt + (size_t)nxt.pn * tstep : cB;
        for (int t = 0; t < nt; t += 2) {
            const bool last = (t == nt - 2);
            const char* a1 = cA + (size_t)(t + 1) * kstep;
            const char* a2 = last ? nA : cA + (size_t)(t + 2) * kstep; const char* b2 = last ? nB : cB + (size_t)(t + 2) * kstep;
            const char* a3 = a2 + kstep; const char* b3 = b2 + kstep;
            PG8_LDB(B0, 0, 0); PG8_LDB(B1, 0, 1); PG8_SCHED; PG8_LDA(At, 0, 0); PG8_STAGE(PG8_SA(1, 1), a1 + hstep, voffA);
            PG8_WAIT_V(8); PG8_WAIT_L(0); PG8_BAR; PG8_MMA(0, 0, At, B0); PG8_MMA(0, 1, At, B1); PG8_BAR; PG8_SCHED;
            PG8_LDA(At, 0, 1); PG8_STAGE(PG8_SB(0, 0), b2, voffB); PG8_STAGE(PG8_SB(0, 1), b2 + hstep, voffB); PG8_STAGE(PG8_SA(0, 0), a2, voffA);
            PG8_WAIT_V(8); PG8_WAIT_L(0); PG8_BAR; PG8_MMA(1, 0, At, B0); PG8_MMA(1, 1, At, B1); PG8_BAR; PG8_SCHED;
            PG8_LDB(B0, 1, 0); PG8_LDB(B1, 1, 1); PG8_SCHED; PG8_LDA(At, 1, 0); PG8_STAGE(PG8_SA(0, 1), a2 + hstep, voffA);
            PG8_WAIT_V(8); PG8_WAIT_L(0); PG8_BAR; PG8_MMA(0, 0, At, B0); PG8_MMA(0, 1, At, B1); PG8_BAR; PG8_SCHED;
            PG8_LDA(At, 1, 1); PG8_STAGE(PG8_SB(1, 0), b3, voffB); PG8_STAGE(PG8_SB(1, 1), b3 + hstep, voffB); PG8_STAGE(PG8_SA(1, 0), a3, voffA);
            PG8_WAIT_V(8); PG8_WAIT_L(0); PG8_BAR; PG8_MMA(1, 0, At, B0); PG8_MMA(1, 1, At, B1); PG8_BAR; PG8_SCHED;
        }
        if (wr == 0) PG8_BAR;
        E(acc, cur, wr, wc, fr, fq);
        if (!has_next) break;
#pragma unroll
        for (int a = 0; a < 2; ++a)
#pragma unroll
            for (int b = 0; b < 2; ++b)
#pragma unroll
                for (int m = 0; m < 4; ++m)
#pragma unroll
                    for (int n = 0; n < 2; ++n) acc[a][b][m][n] = (f32x4){0.f, 0.f, 0.f, 0.f};
        cur = nxt; cA = nA; cB = nB; ++ui;
        if (wr == 1) PG8_BAR;
    }
    PG8_WAIT_V(0);
    PG8_BAR;
#undef PG8_SA
#undef PG8_SB
#undef PG8_STAGE
#undef PG8_LDA
#undef PG8_LDB
#undef PG8_MMA
#undef PG8_WAIT_V
#undef PG8_WAIT_L
#undef PG8_BAR
#undef PG8_SCHED
}
}

typedef __attribute__((address_space(1))) unsigned gu32;
#define XB_TMO      128
#define XB_XCNT(j)  (256  + 64 * (j))
#define XB_XSUB(j)  (1280 + 64 * (j))
#define XB_XGEN(j)  (2304 + 64 * (j))
#define XB_TOP      3328
#define XB_TOPGEN   3392
#define XCD_BAR_WORDS 3456
#define XB_SPIN_CAP (1u << 18)

__device__ __forceinline__ unsigned xb_ld(unsigned* p)              { return __hip_atomic_load(p, __ATOMIC_RELAXED, __HIP_MEMORY_SCOPE_AGENT); }
__device__ __forceinline__ unsigned xb_add(unsigned* p, unsigned v) { return __hip_atomic_fetch_add(p, v, __ATOMIC_RELAXED, __HIP_MEMORY_SCOPE_AGENT); }
__device__ __forceinline__ unsigned xb_xcc_id() { return (unsigned)__builtin_amdgcn_s_getreg((3 << 11) | 20) & 0xFu; }
#define XB_SPIN(cond, bar) do { unsigned _sp = 0; while (cond) { __builtin_amdgcn_s_sleep(1); \
    if ((++_sp & 255u) == 0u) { if (xb_ld(&(bar)[XB_TMO])) break; if (_sp > XB_SPIN_CAP) { atomicAdd(&(bar)[XB_TMO], 1u); break; } } } } while (0)

struct XcdBarrier {
    unsigned* bar; unsigned x;
    volatile LAS unsigned* st;
};

__device__ __forceinline__ XcdBarrier xcd_barrier_post(unsigned* bar, volatile LAS unsigned* st) {
    XcdBarrier b; b.bar = bar; b.x = xb_xcc_id(); b.st = st;
    if (threadIdx.x == 0) (void)xb_add(&bar[XB_XCNT(b.x)], 1u);
    return b;
}
__device__ __forceinline__ void xcd_barrier_complete(unsigned* bar, unsigned x, unsigned& nloc, unsigned& nx) {
    const unsigned G = gridDim.x * gridDim.y * gridDim.z;
    unsigned sum, cnt, mine, sp = 0u;
    for (;;) {
        sum = 0u; cnt = 0u; mine = 0u;
#pragma unroll
        for (unsigned j = 0; j < 16; ++j) { const unsigned c = xb_ld(&bar[XB_XCNT(j)]); sum += c; cnt += (c > 0u) ? 1u : 0u; mine = (j == x) ? c : mine; }
        if (sum == G) break;
        __builtin_amdgcn_s_sleep(1);
        if ((++sp & 255u) == 0u) { if (xb_ld(&bar[XB_TMO])) break; if (sp > XB_SPIN_CAP) { atomicAdd(&bar[XB_TMO], 1u); break; } }
    }
    nloc = mine > 0u ? mine : 1u; nx = cnt > 0u ? cnt : 1u;
}

__device__ __forceinline__ void xcd_barrier(const XcdBarrier& b) {
    asm volatile("s_waitcnt vmcnt(0)" ::: "memory");
    __syncthreads();
    if (threadIdx.x == 0) {
        unsigned* bar = b.bar;
        __builtin_amdgcn_s_waitcnt(0);
        unsigned nloc = b.st[0], nx = b.st[1];
        if (nloc == 0u) { xcd_barrier_complete(bar, b.x, nloc, nx); b.st[0] = nloc; b.st[1] = nx; }
        const unsigned old = xb_add(&bar[XB_XSUB(b.x)], 1u);
        const unsigned gen = old / nloc;
        if (old + 1u == (gen + 1u) * nloc) {
            __builtin_amdgcn_fence(__ATOMIC_RELEASE, "agent");
            asm volatile("s_waitcnt vmcnt(0)" ::: "memory");
            const unsigned og = xb_add(&bar[XB_TOP], 1u);
            const unsigned tg = og / nx;
            if (og + 1u == (tg + 1u) * nx) xb_add(&bar[XB_TOPGEN], 1u);
            else XB_SPIN(xb_ld(&bar[XB_TOPGEN]) == tg, bar);
            __builtin_amdgcn_fence(__ATOMIC_ACQUIRE, "agent");
            xb_add(&bar[XB_XGEN(b.x)], 1u);
            asm volatile("s_waitcnt vmcnt(0)" ::: "memory");
        } else {
            XB_SPIN(xb_ld(&bar[XB_XGEN(b.x)]) == gen, bar);
            __builtin_amdgcn_fence(__ATOMIC_ACQUIRE, "agent");
            asm volatile("s_waitcnt vmcnt(0)" ::: "memory");
        }
    }
    __syncthreads();
}


struct Args { const float* in[19]; float* out; unsigned char* ws; int ph_lo, ph_hi; };
enum { I_X = 0, I_MEM, I_NORM_MIX, I_W_IN, I_UP_F, I_BIAS_F, I_UP_B, I_BIAS_B, I_GLA_NORM, I_REL, I_DIL_NORM, I_MEM_NORM, I_W_MKV, I_MEM_ONORM, I_W_OUT, I_NORM_MLP, I_W_UP, I_W_DOWN, I_NORM_FINAL };
typedef const __attribute__((address_space(4))) Args* ArgsP;
constexpr int NPHASE = 1 + 7 * DEPTH + 1;

constexpr int TS = 272;
struct TrJob { const float* src; const float* gain; bf16_t* dst; int K, N, mode, kb, nb4, nblk; bool valid; };
__device__ __forceinline__ int colblk_map(int mode, int sb) { return mode == 0 ? sb : (sb < 96 ? sb : (sb == 96 ? 160 : sb - 1)); }
__device__ __forceinline__ TrJob tr_job(ArgsP a, int it) {
    TrJob j; j.valid = true; j.gain = nullptr; j.mode = 0;
    int r = it, l, nbn;
    bf16_t* ws16;
    if (r < 4 * 656) { l = r / 656; r -= l * 656; j.K = DM; j.N = NIN_SRC; j.src = a->in[I_W_IN] + (size_t)l * DM * NIN_SRC; j.gain = a->in[I_NORM_MIX] + l * DM; ws16 = l == 0 ? (bf16_t*)(a->ws + WS_WIN0) : (bf16_t*)(a->ws + WS_WIN) + (size_t)l * NIN * DM; j.mode = 1; nbn = 41; }
    else if ((r -= 4 * 656) < 4 * 256) { l = r / 256; r -= l * 256; j.K = DM; j.N = DM; j.src = a->in[I_W_OUT] + (size_t)l * DM * DM; ws16 = (bf16_t*)(a->ws + WS_WOUT) + (size_t)l * DM * DM; nbn = 16; }
    else if ((r -= 4 * 256) < 4 * 1024) { l = r / 1024; r -= l * 1024; j.K = DM; j.N = DFF; j.src = a->in[I_W_UP] + (size_t)l * DM * DFF; j.gain = a->in[I_NORM_MLP] + l * DM; ws16 = (bf16_t*)(a->ws + WS_WUP) + (size_t)l * DFF * DM; nbn = 64; }
    else if ((r -= 4 * 1024) < 4 * 1024) { l = r / 1024; r -= l * 1024; j.K = DFF; j.N = DM; j.src = a->in[I_W_DOWN] + (size_t)l * DFF * DM; ws16 = (bf16_t*)(a->ws + WS_WDN) + (size_t)l * DM * DFF; nbn = 16; }
    else if ((r -= 4 * 1024) < 4 * 128) { l = r / 128; r -= l * 128; j.K = DM; j.N = 1024; j.src = a->in[I_W_MKV] + (size_t)l * DM * 1024; j.gain = a->in[I_MEM_NORM] + l * DM; ws16 = (bf16_t*)(a->ws + WS_WMKV2) + (size_t)l * 1024 * DM; nbn = 8; }
    else { j.valid = false; j.K = 0; j.N = 0; j.src = nullptr; ws16 = nullptr; nbn = 1; r = 0; }
    j.dst = ws16; j.kb = r / nbn; j.nb4 = r % nbn; j.nblk = j.N / 32;
    return j;
}
constexpr int N_TR_ITEMS = 4 * (656 + 256 + 1024 + 1024 + 128);
__device__ __forceinline__ void tr_load(const TrJob& j, f32x4 (&v)[8]) {
    const int tid = tid_op(), cq = tid & 31, k0 = tid >> 5;
    const bool ok = j.valid && (4 * j.nb4 + (cq >> 3)) < j.nblk;
#pragma unroll
    for (int i = 0; i < 8; ++i) {
        const int k = 128 * j.kb + 16 * i + k0;
        if (ok) { const f32x4 x = *(const f32x4*)(j.src + (size_t)k * j.N + 128 * j.nb4 + 4 * cq); const float g = j.gain ? j.gain[k] : 1.0f; v[i] = x * g; }
        else v[i] = (f32x4){0.f, 0.f, 0.f, 0.f};
    }
}
__device__ __forceinline__ void tr_store(const TrJob& j, const f32x4 (&v)[8], LAS unsigned char* lds) {
    const int tid = tid_op(), cq = tid & 31, k0 = tid >> 5, lane = tid & 63, w = __builtin_amdgcn_readfirstlane(tid >> 6), g = lane >> 4, i = lane & 15;
#pragma unroll
    for (int q = 0; q < 8; ++q) { u32x2 p; p.x = pk2(v[q][0], v[q][1]); p.y = pk2(v[q][2], v[q][3]); *(LAS u32x2*)(lds + (16 * q + k0) * TS + 8 * cq) = p; }
    __syncthreads();
    const int kq = w & 3;
#pragma unroll
    for (int c = 0; c < 4; ++c) {
        const int nq = (w >> 2) * 4 + c, sb = 4 * j.nb4 + (nq >> 1);
        if (sb < j.nblk) {
            const LAS unsigned char* p0 = lds + (32 * kq + 8 * g + (i >> 2)) * TS + (16 * nq + 4 * (i & 3)) * 2;
            const bf16x8 t = tr8(p0, p0 + 4 * TS);
            const int drow = colblk_map(j.mode, sb) * 32 + (nq & 1) * 16 + i;
            *(bf16x8*)(j.dst + (size_t)drow * j.K + 128 * j.kb + 32 * kq + 8 * g) = t;
        }
    }
    __syncthreads();
}
__device__ __forceinline__ void prep_row(const float* src, float* dstf, bf16_t* dstb, float* ssq, int lane) {
    float s = 0.f;
#pragma unroll
    for (int jj = 0; jj < 8; ++jj) {
        const f32x4 v = *((const f32x4*)src + 64 * jj + lane);
        if (dstf) *((f32x4*)dstf + 64 * jj + lane) = v;
        u32x2 p; p.x = pk2(v[0], v[1]); p.y = pk2(v[2], v[3]);
        *((u32x2*)dstb + 64 * jj + lane) = p;
        s += (v[0] * v[0] + v[1] * v[1]) + (v[2] * v[2] + v[3] * v[3]);
    }
    s = wave_sum(s);
    if (lane < 32) ssq[lane] = lane == 0 ? s : 0.f;
}
__device__ __forceinline__ void phase_prep(ArgsP a, LAS unsigned char* lds) {
    const int tid = tid_op(), lane = tid & 63, w = __builtin_amdgcn_readfirstlane(tid >> 6);
    const int G = gridDim.x, gw = bid_op() * 8 + w, NGW = G * 8;
    for (int r = gw; r < SEQ; r += NGW) prep_row(a->in[I_X] + (size_t)r * DM, nullptr, (bf16_t*)(a->ws + WS_XB2) + (size_t)r * DM, (float*)(a->ws + WS_SSQ) + (size_t)r * 32, lane);
    for (int r = gw; r < MEML; r += NGW) prep_row(a->in[I_MEM] + (size_t)r * DM, nullptr, (bf16_t*)(a->ws + WS_MEMB2) + (size_t)r * DM, (float*)(a->ws + WS_SSQM) + (size_t)r * 32, lane);
    { const size_t per = (size_t)(NIN - NIN_SRC) * DM * 2 / 16;
      for (size_t c = (size_t)bid_op() * 512 + tid; c < 4 * per; c += (size_t)G * 512) { const size_t l = c / per, o = c % per;
          *(u32x4*)(a->ws + (l == 0 ? WS_WIN0 : WS_WIN + l * NIN * DM * 2) + (size_t)NIN_SRC * DM * 2 + o * 16) = (u32x4){0u, 0u, 0u, 0u}; } }
    f32x4 v[8];
    int it = bid_op();
    TrJob cur = tr_job(a, it);
    if (it < N_TR_ITEMS) tr_load(cur, v);
    while (it < N_TR_ITEMS) {
        const int nit = it + G;
        const int cq = tid & 31, k0 = tid >> 5;
#pragma unroll
        for (int q = 0; q < 8; ++q) { u32x2 p; p.x = pk2(v[q][0], v[q][1]); p.y = pk2(v[q][2], v[q][3]); *(LAS u32x2*)(lds + (16 * q + k0) * TS + 8 * cq) = p; }
        __syncthreads();
        const TrJob nxt = tr_job(a, nit < N_TR_ITEMS ? nit : 0);
        if (nit < N_TR_ITEMS) tr_load(nxt, v);
        { const int g = lane >> 4, i = lane & 15, kq = w & 3;
#pragma unroll
          for (int c = 0; c < 4; ++c) {
              const int nq = (w >> 2) * 4 + c, sb = 4 * cur.nb4 + (nq >> 1);
              if (sb < cur.nblk) {
                  const LAS unsigned char* p0 = lds + (32 * kq + 8 * g + (i >> 2)) * TS + (16 * nq + 4 * (i & 3)) * 2;
                  const bf16x8 t = tr8(p0, p0 + 4 * TS);
                  const int drow = colblk_map(cur.mode, sb) * 32 + (nq & 1) * 16 + i;
                  *(bf16x8*)(cur.dst + (size_t)drow * cur.K + 128 * cur.kb + 32 * kq + 8 * g) = t;
              }
          } }
        __syncthreads();
        cur = nxt; it = nit;
    }
}

constexpr int AST = 272;
template <int NTS, int NT, bool MASK>
__device__ __forceinline__ void attn_core(const LAS unsigned char* Kb, const LAS unsigned char* Vb, const bf16x8 (&qf)[4], const LAS float* tabp, bool edge, int klo, int khi,
                                          f32x4 (&o)[8], float& mrow, float& den) {
    const int lane = tid_op() & 63, g = lane >> 4, i = lane & 15;
    f32x4 s[NTS];
#pragma unroll
    for (int t = 0; t < NTS; ++t) {
        s[t] = (f32x4){0.f, 0.f, 0.f, 0.f};
#pragma unroll
        for (int ks = 0; ks < 4; ++ks) {
            const bf16x8 kf = *(const LAS bf16x8*)(Kb + (16 * t + i) * AST + (32 * ks + 8 * g) * 2);
            s[t] = mfma16(kf, qf[ks], s[t]);
        }
    }
    constexpr float C2 = QSCALE * 1.4426950408889634f;
    float mx = -3.0e38f;
#pragma unroll
    for (int t = 0; t < NTS; ++t) {
        f32x2 lo = (f32x2){s[t][0], s[t][1]}, hi = (f32x2){s[t][2], s[t][3]};
        if (MASK) { const f32x2 tl = (f32x2){tabp[16 * t], tabp[16 * t + 1]}, th = (f32x2){tabp[16 * t + 2], tabp[16 * t + 3]}; lo = lo * C2 + tl; hi = hi * C2 + th; }
        else { lo = lo * C2; hi = hi * C2; }
        s[t] = (f32x4){lo.x, lo.y, hi.x, hi.y};
        mx = fmaxf(fmaxf(mx, lo.x), fmaxf(lo.y, fmaxf(hi.x, hi.y)));
    }
    if (MASK && edge) {
        mx = -3.0e38f;
#pragma unroll
        for (int t = 0; t < NTS; ++t)
#pragma unroll
            for (int r = 0; r < 4; ++r) { const int kq = 16 * t + r; const float v = (kq >= klo && kq < khi) ? s[t][r] : -1.0e30f; s[t][r] = v; mx = fmaxf(mx, v); }
    }
    mx = fmaxf(mx, __shfl_xor(mx, 16)); mx = fmaxf(mx, __shfl_xor(mx, 32));
    f32x2 sum2 = (f32x2){0.f, 0.f};
    const f32x2 nmx = (f32x2){-mx, -mx};
#pragma unroll
    for (int t = 0; t < NTS; ++t) {
        const f32x2 dl = (f32x2){s[t][0], s[t][1]} + nmx, dh = (f32x2){s[t][2], s[t][3]} + nmx;
        const f32x2 pl = (f32x2){__builtin_amdgcn_exp2f(dl.x), __builtin_amdgcn_exp2f(dl.y)}, ph = (f32x2){__builtin_amdgcn_exp2f(dh.x), __builtin_amdgcn_exp2f(dh.y)};
        s[t] = (f32x4){pl.x, pl.y, ph.x, ph.y};
        sum2 = sum2 + pl; sum2 = sum2 + ph;
    }
    float sum = sum2.x + sum2.y;
    sum += __shfl_xor(sum, 16); sum += __shfl_xor(sum, 32);
#pragma unroll
    for (int et = 0; et < 8; ++et) o[et] = (f32x4){0.f, 0.f, 0.f, 0.f};
#pragma unroll
    for (int kk = 0; kk < NT / 2; ++kk) {
        u32x4 pw; pw.x = pk2(s[2 * kk][0], s[2 * kk][1]); pw.y = pk2(s[2 * kk][2], s[2 * kk][3]);
        if (2 * kk + 1 < NTS) { pw.z = pk2(s[2 * kk + 1 < NTS ? 2 * kk + 1 : 0][0], s[2 * kk + 1 < NTS ? 2 * kk + 1 : 0][1]); pw.w = pk2(s[2 * kk + 1 < NTS ? 2 * kk + 1 : 0][2], s[2 * kk + 1 < NTS ? 2 * kk + 1 : 0][3]); }
        else { pw.z = 0u; pw.w = 0u; }
        const bf16x8 pf = __builtin_bit_cast(bf16x8, pw);
#pragma unroll
        for (int et = 0; et < 8; ++et) {
            const LAS unsigned char* p0 = Vb + (32 * kk + 4 * g + (i >> 2)) * AST + (16 * et + 4 * (i & 3)) * 2;
            const bf16x8 vf = tr8(p0, p0 + 16 * AST);
            o[et] = mfma16(vf, pf, o[et]);
        }
    }
    mrow = mx; den = sum;
}

struct DilGeom { int pb, h, r, dsh, d, lsub, npairs, rr, p, tq0, tk0; };
__device__ __forceinline__ DilGeom dil_geom(int item) {
    DilGeom q; q.pb = item & 63; q.h = (item >> 6) & 3; q.r = item >> 8; q.dsh = 2 * q.r; q.d = 1 << q.dsh; q.lsub = SEQ >> q.dsh; q.npairs = 64 >> q.dsh;
    q.rr = q.pb / q.npairs; q.p = q.pb % q.npairs; q.tq0 = 128 * q.p; q.tk0 = 128 * q.p - 64; return q;
}
constexpr int DIL_TAB = 2 * 272 * AST;
__device__ __forceinline__ void dil_load(ArgsP a, int item, u32x4 (&kr)[8], u32x4 (&vr)[8]) {
    const int tid = tid_op(); const DilGeom q = dil_geom(item);
    const bf16_t* proj = (const bf16_t*)(a->ws + WS_PROJ);
#pragma unroll
    for (int j = 0; j < 8; ++j) {
        const int c = tid + 512 * j, ki = c >> 4, ch = c & 15, t = q.tk0 + ki;
        kr[j] = (u32x4){0u, 0u, 0u, 0u}; vr[j] = kr[j];
        if (t >= 0 && t < q.lsub) { const size_t pos = ((size_t)t << q.dsh) + q.rr; const bf16_t* row = proj + pos * NIN + q.h * 128 + 8 * ch; kr[j] = *(const u32x4*)(row + DKo); vr[j] = *(const u32x4*)(row + DVo); }
    }
}
__device__ __forceinline__ void dil_store(ArgsP a, int item, const u32x4 (&kr)[8], const u32x4 (&vr)[8], LAS unsigned char* lds) {
    const int tid = tid_op(); const DilGeom q = dil_geom(item);
    LAS unsigned char* Ks = lds; LAS unsigned char* Vs = lds + 272 * AST; LAS float* tab = (LAS float*)(lds + DIL_TAB);
#pragma unroll
    for (int j = 0; j < 8; ++j) { const int c = tid + 512 * j, ki = c >> 4, ch = c & 15; *(LAS u32x4*)(Ks + ki * AST + 16 * ch) = kr[j]; *(LAS u32x4*)(Vs + ki * AST + 16 * ch) = vr[j]; }
    if (tid < 256) { const int ki = 256 + (tid >> 4), ch = tid & 15; *(LAS u32x4*)(Ks + ki * AST + 16 * ch) = (u32x4){0u, 0u, 0u, 0u}; *(LAS u32x4*)(Vs + ki * AST + 16 * ch) = (u32x4){0u, 0u, 0u, 0u}; }
    if (tid >= 256 && tid < 448) {
        const int m = tid - 256, rel = m - 79; float v = -1.0e30f;
        if (rel >= -64 && rel <= 64) {
            const int n = (rel < 0 ? -rel : rel) * q.d;
            const float nf = (float)(n < 1 ? 1 : n);
            int large = 8 + (int)(logf(nf / 8.0f) / 4.852030263919617f * 8.0f);
            large = large < 15 ? large : 15;
            const int bucket = (rel > 0 ? 16 : 0) + (n < 8 ? n : large);
            v = a->in[I_REL][bucket * 4 + q.h] * 1.4426950408889634f;
        }
        tab[m] = v;
    }
}
__device__ __forceinline__ void dil_compute(ArgsP a, int item, LAS unsigned char* lds) {
    const int tid = tid_op(), lane = tid & 63, w = __builtin_amdgcn_readfirstlane(tid >> 6), g = lane >> 4, i = lane & 15;
    const DilGeom q = dil_geom(item);
    const bf16_t* proj = (const bf16_t*)(a->ws + WS_PROJ);
    const LAS unsigned char* Ks = lds; const LAS unsigned char* Vs = lds + 272 * AST; const LAS float* tab = (const LAS float*)(lds + DIL_TAB);
    bf16x8 qf[4];
    const size_t qpos = ((size_t)(q.tq0 + 16 * w + i) << q.dsh) + q.rr;
#pragma unroll
    for (int ks = 0; ks < 4; ++ks) qf[ks] = *(const bf16x8*)(proj + qpos * NIN + DQ + q.h * 128 + 32 * ks + 8 * g);
    const bool edge = (q.p == 0) || (q.p == q.npairs - 1);
    const int kbase = q.tk0 + 16 * w + 4 * g;
    const int klo = -kbase, khi = q.lsub - kbase;
    f32x4 o[8]; float m, den;
    attn_core<9, 10, true>(Ks + 16 * w * AST, Vs + 16 * w * AST, qf, tab + (4 * g - i + 15), edge, klo, khi, o, m, den);
    const float inv = 1.0f / den;
    bf16_t* dst = (bf16_t*)(a->ws + WS_DILO) + ((size_t)q.r * SEQ + qpos) * 512 + q.h * 128 + 4 * g;
#pragma unroll
    for (int et = 0; et < 8; ++et) { u32x2 pv; pv.x = pk2(o[et][0] * inv, o[et][1] * inv); pv.y = pk2(o[et][2] * inv, o[et][3] * inv); *(u32x2*)(dst + 16 * et) = pv; }
    if (g == 0) ((float*)(a->ws + WS_DILL))[((size_t)q.r * SEQ + qpos) * 4 + q.h] = m * 0.6931471805599453f + logf(den);
}
__device__ __forceinline__ int dil_items(ArgsP a, int d0, int stride, LAS unsigned char* lds) {
    u32x4 kr[8], vr[8];
    int d = d0;
    if (d < 768) dil_load(a, d, kr, vr);
    while (d < 768) {
        dil_store(a, d, kr, vr, lds);
        __syncthreads();
        const int nd = d + stride;
        if (nd < 768) dil_load(a, nd, kr, vr);
        dil_compute(a, d, lds);
        __syncthreads();
        d = nd;
    }
    return d;
}

__device__ __forceinline__ void mem_item(ArgsP a, int layer, int item, LAS unsigned char* lds) {
    const int tid = tid_op(), lane = tid & 63, w = __builtin_amdgcn_readfirstlane(tid >> 6), g = lane >> 4, i = lane & 15;
    const int h = item & 3, qb = item >> 2;
    const bf16_t* proj = (const bf16_t*)(a->ws + WS_PROJ);
    const bf16_t* mkv = (const bf16_t*)(a->ws + WS_MEMKV);
    LAS unsigned char* Ks = lds; LAS unsigned char* Vs = lds + 272 * AST;
    for (int c = tid; c < 256 * 16; c += 512) {
        const int ki = c >> 4, ch = c & 15;
        const bf16_t* row = mkv + (size_t)ki * 4096 + layer * 1024 + h * 128 + 8 * ch;
        *(LAS u32x4*)(Ks + ki * AST + 16 * ch) = *(const u32x4*)row; *(LAS u32x4*)(Vs + ki * AST + 16 * ch) = *(const u32x4*)(row + 512);
    }
    __syncthreads();
    bf16x8 qf[4];
    const size_t qpos = (size_t)qb * 128 + 16 * w + i;
#pragma unroll
    for (int ks = 0; ks < 4; ++ks) qf[ks] = *(const bf16x8*)(proj + qpos * NIN + MQ + h * 128 + 32 * ks + 8 * g);
    f32x4 o[8]; float m, den;
    attn_core<16, 16, false>(Ks, Vs, qf, nullptr, false, 0, 0, o, m, den);
    const float inv = 1.0f / den;
    float ss = 0.f;
#pragma unroll
    for (int et = 0; et < 8; ++et) { o[et] = o[et] * inv; ss += (o[et][0] * o[et][0] + o[et][1] * o[et][1]) + (o[et][2] * o[et][2] + o[et][3] * o[et][3]); }
    ss += __shfl_xor(ss, 16); ss += __shfl_xor(ss, 32);
    const float rs = __builtin_amdgcn_rsqf(ss * (1.0f / 128.0f) + EPS);
    const float* gn = a->in[I_MEM_ONORM] + layer * 512 + h * 128 + 4 * g;
    bf16_t* dst = (bf16_t*)(a->ws + WS_MIX) + qpos * DM + 1536 + h * 128 + 4 * g;
#pragma unroll
    for (int et = 0; et < 8; ++et) { const f32x4 gv = *(const f32x4*)(gn + 16 * et); const f32x4 v = o[et] * rs * gv; u32x2 pv; pv.x = pk2(v[0], v[1]); pv.y = pk2(v[2], v[3]); *(u32x2*)(dst + 16 * et) = pv; }
    __syncthreads();
}

constexpr int VST = 528;
constexpr int G1_LR = 0, G1_TOT = 8192, G1_KE = 10240, G1_V = G1_KE + 2 * 64 * 272, G1_B = G1_V + 64 * VST, G1_EB = G1_B + 2 * 64 * 128 * 4;
__device__ __forceinline__ void gla1_item(ArgsP a, int layer, int item, LAS unsigned char* lds) {
    const int tid = tid_op(), lane = tid & 63, w = __builtin_amdgcn_readfirstlane(tid >> 6), g = lane >> 4, i = lane & 15;
    const int n = item >> 2, h = item & 3, pos0 = 64 * n;
    const bf16_t* proj = (const bf16_t*)(a->ws + WS_PROJ);
    LAS float* lrs = (LAS float*)(lds + G1_LR);
    LAS float* tots = (LAS float*)(lds + G1_TOT);
    LAS unsigned char* KE = lds + G1_KE;
    LAS unsigned char* Vs = lds + G1_V;
    LAS float* Bs = (LAS float*)(lds + G1_B);
    LAS float* EB = (LAS float*)(lds + G1_EB);
    u32x4 q8[2], k8[2];
#pragma unroll
    for (int jj = 0; jj < 2; ++jj) { const int id = tid + 512 * jj, c = id >> 4, ch = id & 15; const bf16_t* rp = proj + (size_t)(pos0 + c) * NIN + h * 128 + 8 * ch;
        q8[jj] = *(const u32x4*)(rp + PQ); k8[jj] = *(const u32x4*)(rp + PK); }
    { const int c = tid >> 3, q4 = tid & 7;
      const u32x2 v = *(const u32x2*)(proj + (size_t)(pos0 + c) * NIN + LRF + 4 * q4);
      *(LAS f32x4*)(lrs + ((q4 >> 2) * 64 + c) * 16 + (q4 & 3) * 4) = (f32x4){bflo(v.x), bfhi(v.x), bflo(v.y), bfhi(v.y)}; }
#pragma unroll
    for (int jj = 0; jj < 4; ++jj) { const int id = tid + 512 * jj, c = id >> 5, ch = id & 31;
        *(LAS u32x4*)(Vs + c * VST + 16 * ch) = *(const u32x4*)(proj + (size_t)(pos0 + c) * NIN + PV + h * 256 + 8 * ch); }
    __syncthreads();
    {
        const int dir = tid >> 8, half = (tid >> 7) & 1, dk = tid & 127, col = h * 128 + dk;
        const float* up = a->in[dir ? I_UP_B : I_UP_F] + (size_t)layer * 16 * 512 + col;
        float upr[16];
#pragma unroll
        for (int r = 0; r < 16; ++r) upr[r] = up[r * 512];
        const float bias = a->in[dir ? I_BIAS_B : I_BIAS_F][layer * 512 + col];
        float gv[32];
#pragma unroll
        for (int jj = 0; jj < 32; ++jj) {
            const LAS f32x4* lp = (const LAS f32x4*)(lrs + (dir * 64 + half * 32 + jj) * 16);
            float lg = bias;
#pragma unroll
            for (int q = 0; q < 4; ++q) { const f32x4 lv = lp[q]; lg += lv[0] * upr[4 * q] + lv[1] * upr[4 * q + 1] + lv[2] * upr[4 * q + 2] + lv[3] * upr[4 * q + 3]; }
            const float l2 = __builtin_amdgcn_logf(1.0f + __builtin_amdgcn_exp2f(fabsf(lg) * -1.4426950408889634f));
            gv[jj] = fmaf(__builtin_amdgcn_fmed3f(lg, -3.0e38f, 0.f), 1.4426950408889634f / 16.0f, l2 * (-1.0f / 16.0f));
        }
        float tot;
        if (dir == 0) {
#pragma unroll
            for (int jj = 1; jj < 32; ++jj) gv[jj] += gv[jj - 1];
            tot = gv[31];
        } else {
#pragma unroll
            for (int jj = 30; jj >= 0; --jj) gv[jj] += gv[jj + 1];
            tot = gv[0];
        }
        tots[(dir * 2 + half) * 128 + dk] = tot;
        __syncthreads();
        const float t0 = tots[(dir * 2) * 128 + dk], t1 = tots[(dir * 2 + 1) * 128 + dk], blast = t0 + t1;
        const float add = dir == 0 ? (half == 1 ? t0 : 0.f) : (half == 0 ? t1 : 0.f);
#pragma unroll
        for (int jj = 0; jj < 32; ++jj) Bs[(dir * 64 + half * 32 + jj) * 128 + dk] = gv[jj] + add;
        if (half == 0) { const float eb = __builtin_amdgcn_exp2f(blast); EB[dir * 128 + dk] = eb; ((float*)(a->ws + WS_DEC))[((size_t)dir * 128 + n) * 512 + col] = eb; }
    }
    __syncthreads();
    {
        bf16_t* qd = (bf16_t*)(a->ws + WS_QD); bf16_t* ki = (bf16_t*)(a->ws + WS_KI);
#pragma unroll
        for (int jj = 0; jj < 2; ++jj) {
            const int id = tid + 512 * jj, c = id >> 4, ch = id & 15;
            float qv[8], kv[8];
#pragma unroll
            for (int e = 0; e < 4; ++e) { qv[2 * e] = bflo(q8[jj][e]); qv[2 * e + 1] = bfhi(q8[jj][e]); kv[2 * e] = bflo(k8[jj][e]); kv[2 * e + 1] = bfhi(k8[jj][e]); }
#pragma unroll
            for (int dr = 0; dr < 2; ++dr) {
                const LAS f32x4* bp = (const LAS f32x4*)(Bs + (dr * 64 + c) * 128 + 8 * ch);
                const LAS f32x4* ep = (const LAS f32x4*)(EB + dr * 128 + 8 * ch);
                const f32x4 b0 = bp[0], b1 = bp[1], e0 = ep[0], e1 = ep[1];
                float qo[8], ko[8], eo[8];
#pragma unroll
                for (int e = 0; e < 8; ++e) {
                    const float b = e < 4 ? b0[e & 3] : b1[e & 3], ebl = e < 4 ? e0[e & 3] : e1[e & 3];
                    qo[e] = qv[e] * __builtin_amdgcn_exp2f(b) * QSCALE; ko[e] = kv[e] * __builtin_amdgcn_exp2f(-b); eo[e] = ko[e] * ebl;
                }
                const size_t off = ((size_t)dr * SEQ + pos0 + c) * 512 + h * 128 + 8 * ch;
                u32x4 t; t.x = pk2(qo[0], qo[1]); t.y = pk2(qo[2], qo[3]); t.z = pk2(qo[4], qo[5]); t.w = pk2(qo[6], qo[7]); *(u32x4*)(qd + off) = t;
                t.x = pk2(ko[0], ko[1]); t.y = pk2(ko[2], ko[3]); t.z = pk2(ko[4], ko[5]); t.w = pk2(ko[6], ko[7]); *(u32x4*)(ki + off) = t;
                t.x = pk2(eo[0], eo[1]); t.y = pk2(eo[2], eo[3]); t.z = pk2(eo[4], eo[5]); t.w = pk2(eo[6], eo[7]); *(LAS u32x4*)(KE + (dr * 64 + c) * AST + 16 * ch) = t;
            }
        }
    }
    __syncthreads();
    bf16_t* ST = (bf16_t*)(a->ws + WS_ST);
#pragma unroll 1
    for (int dr = 0; dr < 2; ++dr) {
        f32x4 acc[8][2];
#pragma unroll
        for (int mt = 0; mt < 8; ++mt) { acc[mt][0] = (f32x4){0.f, 0.f, 0.f, 0.f}; acc[mt][1] = acc[mt][0]; }
#pragma unroll
        for (int kk = 0; kk < 2; ++kk) {
            bf16x8 bfr[2];
#pragma unroll
            for (int nt = 0; nt < 2; ++nt) { const LAS unsigned char* p0 = Vs + (32 * kk + 8 * g + (i >> 2)) * VST + (32 * w + 16 * nt + 4 * (i & 3)) * 2; bfr[nt] = tr8(p0, p0 + 4 * VST); }
#pragma unroll
            for (int mt = 0; mt < 8; ++mt) {
                const LAS unsigned char* p0 = KE + (dr * 64 + 32 * kk + 8 * g + (i >> 2)) * AST + (16 * mt + 4 * (i & 3)) * 2;
                const bf16x8 af = tr8(p0, p0 + 4 * AST);
                acc[mt][0] = mfma16(af, bfr[0], acc[mt][0]); acc[mt][1] = mfma16(af, bfr[1], acc[mt][1]);
            }
        }
        const int hd = h * 2 + dr;
#pragma unroll
        for (int nt = 0; nt < 2; ++nt) {
            bf16_t* drow = ST + (((size_t)hd * 128 + n) * 256 + 32 * w + 16 * nt + i) * 128 + 4 * g;
#pragma unroll
            for (int mt = 0; mt < 8; ++mt) { u32x2 pv; pv.x = pk2(acc[mt][nt][0], acc[mt][nt][1]); pv.y = pk2(acc[mt][nt][2], acc[mt][nt][3]); *(u32x2*)(drow + 16 * mt) = pv; }
        }
    }
    __syncthreads();
}

__device__ __forceinline__ void gla_scan(ArgsP a) {
    const int tid = tid_op();
    for (int wgi = bid_op(); wgi < 256; wgi += gridDim.x) {
        const int T = wgi * 512 + tid, dkp = T & 63, dv = (T >> 6) & 255, hd = T >> 14, dir = hd & 1, h = hd >> 1;
        const unsigned* st = (const unsigned*)(a->ws + WS_ST) + ((size_t)hd * 128 * 256 + dv) * 64 + dkp;
        unsigned* so = (unsigned*)(a->ws + WS_ST2) + ((size_t)hd * 128 * 256 + dv) * 64 + dkp;
        const f32x2* dec = (const f32x2*)(a->ws + WS_DEC) + (size_t)dir * 128 * 256 + h * 64 + dkp;
        float s0 = 0.f, s1 = 0.f;
#pragma unroll 1
        for (int nb = 0; nb < 128; nb += 8) {
            unsigned dsv[8]; f32x2 dcv[8];
#pragma unroll
            for (int u = 0; u < 8; ++u) { const int n = dir ? 127 - (nb + u) : nb + u; dsv[u] = st[(size_t)n * 16384]; dcv[u] = dec[(size_t)n * 256]; }
#pragma unroll
            for (int u = 0; u < 8; ++u) { const int n = dir ? 127 - (nb + u) : nb + u;
                so[(size_t)n * 16384] = pk2(s0, s1);
                s0 = dcv[u][0] * s0 + bflo(dsv[u]); s1 = dcv[u][1] * s1 + bfhi(dsv[u]); }
        }
    }
}

constexpr int G3_V = 0, G3_QD = 33792, G3_KI = G3_QD + 34816, G3_AT = G3_KI + 34816, G3_RED = G3_AT + 9216, ATS = 144;
__device__ __forceinline__ void gla3_item(ArgsP a, int layer, int item, LAS unsigned char* lds) {
    const int tid = tid_op(), lane = tid & 63, w = __builtin_amdgcn_readfirstlane(tid >> 6), g = lane >> 4, i = lane & 15;
    const int n = item >> 2, h = item & 3, pos0 = 64 * n;
    const bf16_t* proj = (const bf16_t*)(a->ws + WS_PROJ);
    const bf16_t* QD = (const bf16_t*)(a->ws + WS_QD); const bf16_t* KI = (const bf16_t*)(a->ws + WS_KI);
    LAS unsigned char* Vs = lds + G3_V; LAS unsigned char* Qs = lds + G3_QD; LAS unsigned char* Ksm = lds + G3_KI; LAS unsigned char* AT = lds + G3_AT;
    LAS float* red = (LAS float*)(lds + G3_RED);
    u32x4 sv[4], sq[4], sk[4];
#pragma unroll
    for (int jj = 0; jj < 4; ++jj) { const int id = tid + 512 * jj, c = id >> 5, ch = id & 31;
        sv[jj] = *(const u32x4*)(proj + (size_t)(pos0 + c) * NIN + PV + h * 256 + 8 * ch); }
#pragma unroll
    for (int jj = 0; jj < 4; ++jj) { const int id = tid + 512 * jj, dr = id >> 10, c = (id >> 4) & 63, ch = id & 15;
        const size_t off = ((size_t)dr * SEQ + pos0 + c) * 512 + h * 128 + 8 * ch;
        sq[jj] = *(const u32x4*)(QD + off); sk[jj] = *(const u32x4*)(KI + off); }
    const bf16_t* ST = (const bf16_t*)(a->ws + WS_ST2);
    bf16x8 sf[2][2][4];
#pragma unroll
    for (int dr = 0; dr < 2; ++dr)
#pragma unroll
        for (int et = 0; et < 2; ++et)
#pragma unroll
            for (int ks = 0; ks < 4; ++ks)
                sf[dr][et][ks] = *(const bf16x8*)(ST + ((((size_t)(h * 2 + dr)) * 128 + n) * 256 + 32 * w + 16 * et + i) * 128 + 32 * ks + 8 * g);
#pragma unroll
    for (int jj = 0; jj < 4; ++jj) { const int id = tid + 512 * jj, c = id >> 5, ch = id & 31; *(LAS u32x4*)(Vs + c * VST + 16 * ch) = sv[jj]; }
#pragma unroll
    for (int jj = 0; jj < 4; ++jj) { const int id = tid + 512 * jj, dr = id >> 10, c = (id >> 4) & 63, ch = id & 15;
        *(LAS u32x4*)(Qs + (dr * 64 + c) * AST + 16 * ch) = sq[jj]; *(LAS u32x4*)(Ksm + (dr * 64 + c) * AST + 16 * ch) = sk[jj]; }
    __syncthreads();
#pragma unroll
    for (int j = 0; j < 2; ++j) {
        const int pi = 2 * w + j, st = pi >> 2, ct = pi & 3;
        f32x4 at = (f32x4){0.f, 0.f, 0.f, 0.f};
        if (st <= ct) {
            f32x4 f = (f32x4){0.f, 0.f, 0.f, 0.f};
#pragma unroll
            for (int ks = 0; ks < 4; ++ks) f = mfma16(*(const LAS bf16x8*)(Ksm + (16 * st + i) * AST + (32 * ks + 8 * g) * 2), *(const LAS bf16x8*)(Qs + (16 * ct + i) * AST + (32 * ks + 8 * g) * 2), f);
#pragma unroll
            for (int r = 0; r < 4; ++r) at[r] += (16 * st + 4 * g + r <= 16 * ct + i) ? f[r] : 0.f;
        }
        if (st >= ct) {
            f32x4 f = (f32x4){0.f, 0.f, 0.f, 0.f};
#pragma unroll
            for (int ks = 0; ks < 4; ++ks) f = mfma16(*(const LAS bf16x8*)(Ksm + (64 + 16 * st + i) * AST + (32 * ks + 8 * g) * 2), *(const LAS bf16x8*)(Qs + (64 + 16 * ct + i) * AST + (32 * ks + 8 * g) * 2), f);
#pragma unroll
            for (int r = 0; r < 4; ++r) at[r] += (16 * st + 4 * g + r >= 16 * ct + i) ? f[r] : 0.f;
        }
        u32x2 pv; pv.x = pk2(at[0], at[1]); pv.y = pk2(at[2], at[3]);
        *(LAS u32x2*)(AT + (16 * ct + i) * ATS + (16 * st + 4 * g) * 2) = pv;
    }
    __syncthreads();
    f32x4 o[2][4];
#pragma unroll
    for (int et = 0; et < 2; ++et)
#pragma unroll
        for (int ct = 0; ct < 4; ++ct) o[et][ct] = (f32x4){0.f, 0.f, 0.f, 0.f};
#pragma unroll
    for (int kk = 0; kk < 2; ++kk) {
        bf16x8 vf[2];
#pragma unroll
        for (int et = 0; et < 2; ++et) { const LAS unsigned char* p0 = Vs + (32 * kk + 8 * g + (i >> 2)) * VST + (32 * w + 16 * et + 4 * (i & 3)) * 2; vf[et] = tr8(p0, p0 + 4 * VST); }
#pragma unroll
        for (int ct = 0; ct < 4; ++ct) {
            const bf16x8 bt = *(const LAS bf16x8*)(AT + (16 * ct + i) * ATS + (32 * kk + 8 * g) * 2);
            o[0][ct] = mfma16(vf[0], bt, o[0][ct]); o[1][ct] = mfma16(vf[1], bt, o[1][ct]);
        }
    }
#pragma unroll
    for (int dr = 0; dr < 2; ++dr)
#pragma unroll
        for (int ks = 0; ks < 4; ++ks)
#pragma unroll
            for (int ct = 0; ct < 4; ++ct) {
                const bf16x8 qf = *(const LAS bf16x8*)(Qs + (dr * 64 + 16 * ct + i) * AST + (32 * ks + 8 * g) * 2);
                o[0][ct] = mfma16(sf[dr][0][ks], qf, o[0][ct]); o[1][ct] = mfma16(sf[dr][1][ks], qf, o[1][ct]);
            }
#pragma unroll
    for (int ct = 0; ct < 4; ++ct) {
        float ss = 0.f;
#pragma unroll
        for (int et = 0; et < 2; ++et) ss += (o[et][ct][0] * o[et][ct][0] + o[et][ct][1] * o[et][ct][1]) + (o[et][ct][2] * o[et][ct][2] + o[et][ct][3] * o[et][ct][3]);
        ss += __shfl_xor(ss, 16); ss += __shfl_xor(ss, 32);
        if (g == 0) red[w * 64 + 16 * ct + i] = ss;
    }
    __syncthreads();
    const float* gn = a->in[I_GLA_NORM] + layer * 1024 + h * 256 + 32 * w + 4 * g;
    const f32x4 gv0 = *(const f32x4*)gn, gv1 = *(const f32x4*)(gn + 16);
#pragma unroll
    for (int ct = 0; ct < 4; ++ct) {
        float tot = 0.f;
#pragma unroll
        for (int ww = 0; ww < 8; ++ww) tot += red[ww * 64 + 16 * ct + i];
        const float rs = __builtin_amdgcn_rsqf(tot * (1.0f / 256.0f) + EPS);
        const size_t pos = pos0 + 16 * ct + i;
        const int colb = h * 256 + 32 * w + 4 * g;
        const bf16_t* rp = proj + pos * NIN + PR + colb;
        bf16_t* dst = (bf16_t*)(a->ws + WS_MIX) + pos * DM + colb;
#pragma unroll
        for (int et = 0; et < 2; ++et) {
            const u32x2 rv = *(const u32x2*)(rp + 16 * et);
            const float r0 = bflo(rv.x), r1 = bfhi(rv.x), r2 = bflo(rv.y), r3 = bfhi(rv.y);
            f32x4 v = o[et][ct] * rs * (et ? gv1 : gv0);
            v[0] *= r0 * __builtin_amdgcn_rcpf(1.0f + fexp(-r0)); v[1] *= r1 * __builtin_amdgcn_rcpf(1.0f + fexp(-r1)); v[2] *= r2 * __builtin_amdgcn_rcpf(1.0f + fexp(-r2)); v[3] *= r3 * __builtin_amdgcn_rcpf(1.0f + fexp(-r3));
            u32x2 pv; pv.x = pk2(v[0], v[1]); pv.y = pk2(v[2], v[3]); *(u32x2*)(dst + 16 * et) = pv;
        }
    }
    __syncthreads();
}

__device__ __forceinline__ void dil_combine(ArgsP a, int layer) {
    const int tid = tid_op(), lane = tid & 63, w = __builtin_amdgcn_readfirstlane(tid >> 6), g = lane >> 4, i = lane & 15;
    const int gw = bid_op() * 8 + w, NGW = gridDim.x * 8;
    const bf16_t* DO = (const bf16_t*)(a->ws + WS_DILO); const float* DL = (const float*)(a->ws + WS_DILL);
    for (int wi = gw; wi < SEQ; wi += NGW) {
        const int pair = wi * 4 + g, token = pair >> 2, h = pair & 3;
        const float l0 = DL[((size_t)0 * SEQ + token) * 4 + h], l1 = DL[((size_t)1 * SEQ + token) * 4 + h], l2 = DL[((size_t)2 * SEQ + token) * 4 + h];
        const float mx = fmaxf(l0, fmaxf(l1, l2));
        float w0 = fexp(l0 - mx), w1 = fexp(l1 - mx), w2 = fexp(l2 - mx);
        const float inv = 1.0f / (w0 + w1 + w2); w0 *= inv; w1 *= inv; w2 *= inv;
        const size_t eo = (size_t)token * 512 + h * 128 + 8 * i;
        const u32x4 a0 = *(const u32x4*)(DO + eo), a1 = *(const u32x4*)(DO + (size_t)SEQ * 512 + eo), a2 = *(const u32x4*)(DO + (size_t)2 * SEQ * 512 + eo);
        float v[8];
#pragma unroll
        for (int q = 0; q < 4; ++q) { v[2 * q] = w0 * bflo(a0[q]) + w1 * bflo(a1[q]) + w2 * bflo(a2[q]); v[2 * q + 1] = w0 * bfhi(a0[q]) + w1 * bfhi(a1[q]) + w2 * bfhi(a2[q]); }
        float ss = 0.f;
#pragma unroll
        for (int q = 0; q < 8; ++q) ss += v[q] * v[q];
        ss += __shfl_xor(ss, 1); ss += __shfl_xor(ss, 2); ss += __shfl_xor(ss, 4); ss += __shfl_xor(ss, 8);
        const float rs = __builtin_amdgcn_rsqf(ss * (1.0f / 128.0f) + EPS);
        const float* gn = a->in[I_DIL_NORM] + layer * 512 + h * 128 + 8 * i;
        const f32x4 g0 = *(const f32x4*)gn, g1 = *(const f32x4*)(gn + 4);
        u32x4 ov; ov.x = pk2(v[0] * rs * g0[0], v[1] * rs * g0[1]); ov.y = pk2(v[2] * rs * g0[2], v[3] * rs * g0[3]); ov.z = pk2(v[4] * rs * g1[0], v[5] * rs * g1[1]); ov.w = pk2(v[6] * rs * g1[2], v[7] * rs * g1[3]);
        *(u32x4*)((bf16_t*)(a->ws + WS_MIX) + (size_t)token * DM + 1024 + h * 128 + 8 * i) = ov;
    }
}

__device__ __forceinline__ void phase_final(ArgsP a) {
    const int tid = tid_op(), lane = tid & 63, w = __builtin_amdgcn_readfirstlane(tid >> 6);
    const int gw = bid_op() * 8 + w, NGW = gridDim.x * 8;
    const float* X = (const float*)(a->ws + WS_X); const float* gn = a->in[I_NORM_FINAL];
    for (int r = gw; r < SEQ; r += NGW) {
        f32x4 v[8]; float s = 0.f;
#pragma unroll
        for (int jj = 0; jj < 8; ++jj) { v[jj] = *((const f32x4*)(X + (size_t)r * DM) + 64 * jj + lane); s += (v[jj][0] * v[jj][0] + v[jj][1] * v[jj][1]) + (v[jj][2] * v[jj][2] + v[jj][3] * v[jj][3]); }
        s = wave_sum(s);
        const float rs = 1.0f / sqrtf(s * (1.0f / 2048.0f) + EPS);
#pragma unroll
        for (int jj = 0; jj < 8; ++jj) { const f32x4 gv = *((const f32x4*)gn + 64 * jj + lane); *((f32x4*)(a->out + (size_t)r * DM) + 64 * jj + lane) = v[jj] * rs * gv; }
    }
}


#ifndef DBG_BUF
#define DBG_BUF 0
#endif
__device__ __forceinline__ void phase_dbg(ArgsP a) {
    const int tid = tid_op();
    const bf16_t* proj = (const bf16_t*)(a->ws + WS_PROJ); const bf16_t* mkv = (const bf16_t*)(a->ws + WS_MEMKV); const bf16_t* mix = (const bf16_t*)(a->ws + WS_MIX);
    for (size_t e = (size_t)bid_op() * 512 + tid; e < (size_t)SEQ * DM; e += (size_t)gridDim.x * 512) {
        const size_t r = e / DM, c = e % DM; float v = 0.f;
        if (DBG_BUF == 1) { v = bf2f(proj[r * NIN + c]) + bf2f(proj[r * NIN + c + 2048]) + (c < 1056 ? bf2f(proj[r * NIN + c + 4096]) : 0.f); if (r < 256) v += bf2f(mkv[r * 4096 + c]) + bf2f(mkv[r * 4096 + c + 2048]); }
        if (DBG_BUF == 2) v = bf2f(mix[r * DM + c]);
        if (DBG_BUF == 3) { const bf16_t* qd = (const bf16_t*)(a->ws + WS_QD); const bf16_t* ki = (const bf16_t*)(a->ws + WS_KI); const bf16_t* dl = (const bf16_t*)(a->ws + WS_DILO);
            v = bf2f(qd[r * 512 + (c & 511)]) + bf2f(qd[(SEQ + r) * 512 + (c & 511)]) + bf2f(ki[r * 512 + (c & 511)]) + bf2f(ki[(SEQ + r) * 512 + (c & 511)]) + bf2f(dl[((c >> 9) % 3 * SEQ + r) * 512 + (c & 511)]); }
        if (DBG_BUF == 5) { const bf16_t* qd = (const bf16_t*)(a->ws + WS_QD); const bf16_t* ki = (const bf16_t*)(a->ws + WS_KI); v = bf2f(qd[r * 512 + (c & 511)]) + bf2f(qd[(SEQ + r) * 512 + (c & 511)]) + bf2f(ki[r * 512 + (c & 511)]) + bf2f(ki[(SEQ + r) * 512 + (c & 511)]); }
        if (DBG_BUF == 7) { v = ((const float*)(a->ws + WS_DILL))[e % (3 * SEQ * 4)]; }
        if (DBG_BUF == 4) { const bf16_t* st = (const bf16_t*)(a->ws + WS_ST); v = 0.f; for (int j = 0; j < 16; ++j) v += bf2f(st[e * 16 + j]); }
        a->out[e] = v;
    }
}

#ifndef PROBE_EXTRA_SYNC
#define PROBE_EXTRA_SYNC 0
#endif
#ifndef PROBE_ITEM
#define PROBE_ITEM 0
#endif
#ifndef PROBE_REP_PH
#define PROBE_REP_PH -1
#endif
#ifndef PROBE_REP_SUB
#define PROBE_REP_SUB -1
#endif
__device__ __forceinline__ void run_phase(ArgsP a, int ph, LAS unsigned char* lds, int G) {
        if (ph == 0) { phase_prep(a, lds); return; }
        if (ph == NPHASE - 1) { if (DBG_BUF) phase_dbg(a); else phase_final(a); return; }
        const int layer = (ph - 1) / 7, sub = (ph - 1) % 7;
        if (sub == 0 || sub == 5) {
            pg8::Gemm g; pg8::EpiProj E;
            if (sub == 0) { g = pg8::Gemm{(const bf16_t*)(a->ws + WS_XB2), layer == 0 ? (const bf16_t*)(a->ws + WS_WIN0) : (const bf16_t*)(a->ws + WS_WIN) + (size_t)layer * NIN * DM, SEQ, NIN, DM};
                E = pg8::EpiProj{(bf16_t*)(a->ws + WS_PROJ), NIN, (const float*)(a->ws + WS_SSQ), 0, (bf16_t*)(a->ws + WS_MEMKV), 4096, (const float*)(a->ws + WS_SSQM), 32, 21, (LAS float*)(lds + pg8::STAGE_BYTES)}; }
            else { g = pg8::Gemm{(const bf16_t*)(a->ws + WS_XB2), (const bf16_t*)(a->ws + WS_WUP) + (size_t)layer * DFF * DM, SEQ, DFF, DM};
                E = pg8::EpiProj{(bf16_t*)(a->ws + WS_U), DFF, (const float*)(a->ws + WS_SSQ), 1, nullptr, 0, nullptr, 1 << 20, 0, (LAS float*)(lds + pg8::STAGE_BYTES)}; }
            pg8::StaticOrder S; S.init(g.M, g.N, G, bid_op());
            if (sub == 0 && layer == 0) { S.n_extra = 16; S.ex_pm = 32; S.ex_pn0 = 21; }
            E.fill_row_scales(S);
            pg8::gemm_phase<pg8::EpiProj>(lds, g, S, E);
        } else if (sub == 4 || sub == 6) {
            pg8::Gemm g;
            if (sub == 4) g = pg8::Gemm{(const bf16_t*)(a->ws + WS_MIX), (const bf16_t*)(a->ws + WS_WOUT) + (size_t)layer * DM * DM, SEQ, DM, DM};
            else g = pg8::Gemm{(const bf16_t*)(a->ws + WS_U), (const bf16_t*)(a->ws + WS_WDN) + (size_t)layer * DM * DFF, SEQ, DM, DFF};
            pg8::EpiResid E{(layer == 0 && sub == 4) ? a->in[I_X] : (const float*)(a->ws + WS_X), (float*)(a->ws + WS_X), (bf16_t*)(a->ws + WS_XB2), (float*)(a->ws + WS_SSQ), (layer == DEPTH - 1 && sub == 6) ? 1 : 0};
            pg8::StaticOrder S; S.init(g.M, g.N, G, bid_op());
            pg8::gemm_phase<pg8::EpiResid>(lds, g, S, E);
        } else if (sub == 1) {
            int it = bid_op();
            for (; it < 512; it += G) gla1_item(a, layer, it, lds);
            it = 512 + dil_items(a, it - 512, G, lds);
            for (; it < 1536; it += G) mem_item(a, layer, it - 1280, lds);
        } else if (sub == 2) {
            gla_scan(a);
        } else if (sub == 3) {
            for (int it = bid_op(); it < 512; it += G) { gla3_item(a, layer, it, lds); if (PROBE_ITEM == 4) gla3_item(a, layer, it, lds); }
            dil_combine(a, layer); if (PROBE_ITEM == 5) dil_combine(a, layer);
        }
}

__global__ void __launch_bounds__(512, 2) hymba_fwd(Args a_) {
    extern __shared__ __attribute__((aligned(16))) unsigned char lds_raw[];
    LAS unsigned char* lds = (LAS unsigned char*)lds_raw;
    cg::grid_group grid = cg::this_grid();
    const int G = gridDim.x;
    const int ph_lo = a_.ph_lo, ph_hi = a_.ph_hi;
    if (ph_lo < 0) grid.sync();
    volatile LAS unsigned* misc = (volatile LAS unsigned*)(lds + LDS_MISC);
    if (threadIdx.x < 2) misc[threadIdx.x] = 0u;
    __syncthreads();
    XcdBarrier bar; bar.bar = (unsigned*)(a_.ws + WS_BAR); bar.x = 0; bar.st = nullptr;
    if (ph_hi - ph_lo > 1) bar = xcd_barrier_post((unsigned*)(a_.ws + WS_BAR), misc);
    for (int ph = ph_lo; ph < ph_hi; ++ph) {
        const int nrep = ((PROBE_REP_PH >= 0 && ph == PROBE_REP_PH) || (PROBE_REP_SUB >= 0 && ph >= 1 && ph < NPHASE - 1 && (ph - 1) % 7 == PROBE_REP_SUB)) ? 2 : 1;
        for (int rep = 0; rep < nrep; ++rep) {
            if (ph > ph_lo || rep) { xcd_barrier(bar); for (int xs = 0; xs < PROBE_EXTRA_SYNC; ++xs) xcd_barrier(bar); }
            ArgsP a = (ArgsP)__builtin_amdgcn_kernarg_segment_ptr(); asm volatile("" : "+s"(a));
            run_phase(a, ph, lds, G);
        }
    }
}

extern "C" void kernel_launch(void* const* d_in, const int* in_sizes, int n_in, void* d_out, int out_size, void* d_ws, size_t ws_size, hipStream_t stream) {
    static int grid = 0;
    if (grid == 0) {
        if (n_in != 19 || ws_size < WS_END) { fprintf(stderr, "kernel_launch: unexpected n_in %d / ws_size %zu\n", n_in, ws_size); grid = -1; return; }
        int dev = 0, cus = 0, per_cu = 0;
        (void)hipGetDevice(&dev); (void)hipDeviceGetAttribute(&cus, hipDeviceAttributeMultiprocessorCount, dev);
        if (hipFuncSetAttribute((const void*)hymba_fwd, hipFuncAttributeMaxDynamicSharedMemorySize, LDS_BYTES) != hipSuccess) { fprintf(stderr, "kernel_launch: hipFuncSetAttribute failed\n"); grid = -1; return; }
        if (hipOccupancyMaxActiveBlocksPerMultiprocessor(&per_cu, (const void*)hymba_fwd, 512, LDS_BYTES) != hipSuccess || per_cu < 1) { fprintf(stderr, "kernel_launch: occupancy query gave %d\n", per_cu); per_cu = 1; }
        (void)hipGetLastError();
        grid = cus * per_cu;
    }
    if (grid < 0) return;
    Args a{};
    for (int i = 0; i < 19; ++i) a.in[i] = (const float*)d_in[i];
    a.out = (float*)d_out; a.ws = (unsigned char*)d_ws;
#if MK_MULTI
    for (int ph = 0; ph < NPHASE; ++ph) { if (ph > DBG_LAST && ph != NPHASE - 1) continue; a.ph_lo = ph; a.ph_hi = ph + 1; hipLaunchKernelGGL(hymba_fwd, dim3(grid), dim3(512), LDS_BYTES, stream, a); }
#else
    a.ph_lo = 0; a.ph_hi = NPHASE;
    (void)hipMemsetAsync((unsigned char*)d_ws + WS_BAR, 0, 16384, stream);
    void* args[] = {&a};
    hipError_t e = hipLaunchCooperativeKernel((const void*)hymba_fwd, dim3(grid), dim3(512), args, LDS_BYTES, stream);
    if (e != hipSuccess) fprintf(stderr, "cooperative launch failed: %s (grid %d)\n", hipGetErrorString(e), grid);
#endif
}
```
